# Optimizing an MI355X kernel written in HIP

```python
import jax, jax.numpy as jnp
from jax import lax
import numpy as np

D_MODEL = 1024
BATCH = 8
SEQ = 2048
DEPTH = 2
DEC_BATCH = 32
DEC_SEQ = 16
PAST_LEN = 2048

CHUNK = 64
N_AB = (DEPTH + 1) // 2
N_C = DEPTH // 2
D_FF = 2816
D_MIX = D_MODEL
H_A = 4
DH_A = D_MIX // 2 // H_A
A_WIDTH = H_A * DH_A
H_B = 8
DH_B = D_MIX // 2 // H_B
B_WIDTH = H_B * DH_B
BAND_CHUNKS = 8
BAND_PAST = BAND_CHUNKS * CHUNK
MAX_REL = 128
PROJ_AB = 4 * A_WIDTH + 2 * H_A + 3 * B_WIDTH
R_WIDTH = D_MODEL
N_BLOCKS_C = 8
BW_C = R_WIDTH // N_BLOCKS_C
CONV_W = 4
LRU_C = 8.0
EPS = 1e-6
N_ADA = 9

kernel_name = 'hybrid_mlstm_band_rglru_stream_step'

F32 = jnp.float32


def rmsnorm(x, g):
    xf = x.astype(F32)
    y = xf * lax.rsqrt(jnp.mean(xf * xf, axis=-1, keepdims=True) + EPS)
    return (y * g.astype(F32)).astype(x.dtype)


def swiglu(h, w_in, w_out):
    gate, up = jnp.split(h @ w_in, 2, axis=-1)
    return (jax.nn.silu(gate) * up) @ w_out


def rel_bias(table, rel):
    return table[:, jnp.clip(rel, -MAX_REL, MAX_REL) + MAX_REL].astype(F32)


def mlstm_block(q, k, v, ig, lf, C, n, m):
    L = q.shape[1]
    bt = jnp.swapaxes(jnp.cumsum(lf, axis=1), 1, 2)
    igt = jnp.swapaxes(ig, 1, 2)
    causal = jnp.tril(jnp.ones((L, L), bool))
    logd = jnp.where(causal, bt[..., :, None] - bt[..., None, :] + igt[..., None, :], -jnp.inf)
    inter = bt + m[..., None]
    m_t = jnp.maximum(inter, jnp.max(logd, axis=-1))
    dw = jnp.exp(logd - m_t[..., None])
    iw = jnp.exp(inter - m_t)
    s = jnp.einsum('blhd,bshd->bhls', q, k) * dw
    num = iw[..., None] * jnp.einsum('blhd,bhde->bhle', q, C) + jnp.einsum('bhls,bshe->bhle', s, v)
    den = iw * jnp.einsum('blhd,bhd->bhl', q, n) + jnp.sum(s, axis=-1)
    h = num / jnp.maximum(jnp.abs(den), jnp.exp(-m_t))[..., None]
    b_last = bt[..., -1]
    g = b_last[..., None] - bt + igt
    m_new = jnp.maximum(b_last + m, jnp.max(g, axis=-1))
    w_prev = jnp.exp(b_last + m - m_new)
    w_s = jnp.exp(g - m_new[..., None])
    C_new = w_prev[..., None, None] * C + jnp.einsum('bhs,bshd,bshe->bhde', w_s, k, v)
    n_new = w_prev[..., None] * n + jnp.einsum('bhs,bshd->bhd', w_s, k)
    return jnp.swapaxes(h, 1, 2), C_new, n_new, m_new


def mlstm_chunked(q, k, v, ig, lf, C, n, m):
    Bn, S = q.shape[:2]
    nc = S // CHUNK

    def to_chunks(t):
        return jnp.moveaxis(t.reshape((Bn, nc, CHUNK) + t.shape[2:]), 1, 0)

    def step(carry, inp):
        h, C2, n2, m2 = mlstm_block(*inp, *carry)
        return (C2, n2, m2), h

    (C, n, m), hs = lax.scan(step, (C, n, m), (to_chunks(q), to_chunks(k), to_chunks(v), to_chunks(ig), to_chunks(lf)))
    return jnp.moveaxis(hs, 0, 1).reshape(q.shape[:3] + (v.shape[-1],)), C, n, m


def band_prompt(q, k, v, table):
    Bn, S, H, d = q.shape
    nc = S // CHUNK
    nb = BAND_CHUNKS + 1
    qc = q.reshape(Bn, nc, CHUNK, H, d)
    pad = ((0, 0), (BAND_CHUNKS, 0), (0, 0), (0, 0), (0, 0))
    kp = jnp.pad(k.reshape(Bn, nc, CHUNK, H, d), pad)
    vp = jnp.pad(v.reshape(Bn, nc, CHUNK, H, d), pad)
    kband = jnp.stack([kp[:, o:o + nc] for o in range(nb)], axis=2).reshape(Bn, nc, nb * CHUNK, H, d)
    vband = jnp.stack([vp[:, o:o + nc] for o in range(nb)], axis=2).reshape(Bn, nc, nb * CHUNK, H, d)
    key_off = jnp.arange(nb * CHUNK) - BAND_PAST
    bias = rel_bias(table, key_off[None, :] - jnp.arange(CHUNK)[:, None])
    valid = (jnp.arange(nc)[:, None] - BAND_CHUNKS + (jnp.arange(nb * CHUNK) // CHUNK)[None, :]) >= 0
    s = jnp.einsum('bnqhd,bnkhd->bnhqk', qc, kband).astype(F32) * (DH_B ** -0.5) + bias[None, None]
    s = jnp.where(valid[None, :, None, None, :], s, -jnp.inf)
    pr = jax.nn.softmax(s, axis=-1).astype(v.dtype)
    return jnp.einsum('bnhqk,bnkhd->bnqhd', pr, vband).reshape(Bn, S, H, d)


def band_sample(q, k, v, ck, cv, table):
    W, T = ck.shape[1], q.shape[1]
    kk = jnp.concatenate([ck.astype(k.dtype), k], axis=1)
    vv = jnp.concatenate([cv.astype(v.dtype), v], axis=1)
    bias = rel_bias(table, (jnp.arange(W + T) - W)[None, :] - jnp.arange(T)[:, None])
    s = jnp.einsum('bqhd,bkhd->bhqk', q, kk).astype(F32) * (DH_B ** -0.5) + bias[None]
    pr = jax.nn.softmax(s, axis=-1).astype(v.dtype)
    return jnp.einsum('bhqk,bkhd->bqhd', pr, vv)


def ab_mixer(h, p, i, a_state, b_cache):
    Bn, L, _ = h.shape
    u = h @ p['ab_w_in'][i]
    cuts = [A_WIDTH, 2 * A_WIDTH, 3 * A_WIDTH, 4 * A_WIDTH, 4 * A_WIDTH + 2 * H_A,
            4 * A_WIDTH + 2 * H_A + B_WIDTH, 4 * A_WIDTH + 2 * H_A + 2 * B_WIDTH]
    qa, ka, va, oa, ga, qb, kb, vb = jnp.split(u, cuts, axis=-1)
    qa = qa.reshape(Bn, L, H_A, DH_A).astype(F32)
    ka = ka.reshape(Bn, L, H_A, DH_A).astype(F32) * (DH_A ** -0.5)
    va = va.reshape(Bn, L, H_A, DH_A).astype(F32)
    ga = ga.astype(F32) + p['ab_gate_bias'][i].astype(F32)
    ig, lf = ga[..., :H_A], jax.nn.log_sigmoid(ga[..., H_A:])
    C0, n0, m0 = a_state
    if b_cache is None:
        ha, C1, n1, m1 = mlstm_chunked(qa, ka, va, ig, lf, C0, n0, m0)
    else:
        ha, C1, n1, m1 = mlstm_block(qa, ka, va, ig, lf, C0, n0, m0)
    ha = rmsnorm(ha, p['a_out_norm'][i]) * jax.nn.sigmoid(oa.reshape(Bn, L, H_A, DH_A).astype(F32))
    qb = rmsnorm(qb.reshape(Bn, L, H_B, DH_B), p['b_q_norm'][i])
    kb = rmsnorm(kb.reshape(Bn, L, H_B, DH_B), p['b_k_norm'][i])
    vb = vb.reshape(Bn, L, H_B, DH_B)
    table = p['b_rel_bias'][i]
    if b_cache is None:
        hb = band_prompt(qb, kb, vb, table)
        keep = min(BAND_PAST, L)
        new_k, new_v = kb[:, L - keep:], vb[:, L - keep:]
    else:
        hb = band_sample(qb, kb, vb, b_cache[0], b_cache[1], table)
        new_k, new_v = kb, vb
    mixed = jnp.concatenate([ha.reshape(Bn, L, A_WIDTH).astype(h.dtype), hb.reshape(Bn, L, B_WIDTH)], axis=-1)
    return mixed @ p['ab_w_out'][i], (C1, n1, m1, new_k, new_v)


def _lin_combine(left, right):
    a1, b1 = left
    a2, b2 = right
    return a1 * a2, a2 * b1 + b2


def rglru_mixer(h, p, i, conv_buf, h0):
    Bn, L, _ = h.shape
    gb, xb = jnp.split(h @ p['c_w_in'][i], 2, axis=-1)
    xp = jnp.concatenate([conv_buf.astype(xb.dtype), xb], axis=1)
    w = p['c_conv_w'][i]
    xc = p['c_conv_b'][i] + sum(xp[:, j:j + L] * w[j] for j in range(CONV_W))
    new_buf = xp[:, L:]
    gates = jnp.einsum('blnw,nwv->blnv', xc.reshape(Bn, L, N_BLOCKS_C, BW_C), p['c_gate_w'][i]).astype(F32)
    gates = gates.reshape(Bn, L, N_BLOCKS_C, 2, BW_C)
    gbias = p['c_gate_b'][i].astype(F32)
    r = jax.nn.sigmoid(gates[..., 0, :].reshape(Bn, L, R_WIDTH) + gbias[0])
    ii = jax.nn.sigmoid(gates[..., 1, :].reshape(Bn, L, R_WIDTH) + gbias[1])
    log_a = -LRU_C * r * jax.nn.softplus(-p['c_lambda'][i].astype(F32))
    a = jnp.exp(log_a)
    upd = jnp.sqrt(-jnp.expm1(2.0 * log_a)) * (ii * xc.astype(F32))
    a_cum, u_cum = lax.associative_scan(_lin_combine, (a, upd), axis=1)
    hs = a_cum * h0.astype(F32)[:, None] + u_cum
    y = (jax.nn.gelu(gb.astype(F32)) * hs).astype(h.dtype) @ p['c_w_out'][i]
    return y, (new_buf, hs[:, -1])


def run_trunk(x, c, p, st):
    prompt = st is None
    Bn = x.shape[0]
    out = {name: [] for name in ('a_C', 'a_n', 'a_m', 'b_k', 'b_v', 'c_conv', 'c_h')}
    for l in range(DEPTH):
        ada = (c @ p['ada_w'][l] + p['ada_b'][l]).reshape(Bn, N_ADA, 1, D_MODEL)

        def mod(z, g, j):
            return rmsnorm(z, g) * (1.0 + ada[:, 3 * j + 1]) + ada[:, 3 * j]

        x = x + 0.5 * ada[:, 2] * swiglu(mod(x, p['ffn1_norm'][l], 0), p['ffn1_w_in'][l], p['ffn1_w_out'][l])
        hm = mod(x, p['mix_norm'][l], 1)
        i = l // 2
        if l % 2 == 0:
            if prompt:
                a_state = (jnp.zeros((Bn, H_A, DH_A, DH_A), F32), jnp.zeros((Bn, H_A, DH_A), F32),
                           jnp.zeros((Bn, H_A), F32))
                b_cache = None
            else:
                a_state = (st['a_C'][i].astype(F32), st['a_n'][i].astype(F32), st['a_m'][i].astype(F32))
                b_cache = (st['b_k'][i], st['b_v'][i])
            y, (C1, n1, m1, nk, nv) = ab_mixer(hm, p, i, a_state, b_cache)
            out['a_C'].append(C1)
            out['a_n'].append(n1)
            out['a_m'].append(m1)
            out['b_k'].append(nk)
            out['b_v'].append(nv)
        else:
            if prompt:
                conv_buf = jnp.zeros((Bn, CONV_W - 1, R_WIDTH), x.dtype)
                h0 = jnp.zeros((Bn, R_WIDTH), F32)
            else:
                conv_buf, h0 = st['c_conv'][i], st['c_h'][i]
            y, (nb_, nh) = rglru_mixer(hm, p, i, conv_buf, h0)
            out['c_conv'].append(nb_)
            out['c_h'].append(nh)
        x = x + ada[:, 5] * y
        x = x + 0.5 * ada[:, 8] * swiglu(mod(x, p['ffn2_norm'][l], 2), p['ffn2_w_in'][l], p['ffn2_w_out'][l])
    return x, {name: jnp.stack(v_list, axis=0) for name, v_list in out.items()}


def setup_inputs(seed: int = 0) -> dict:
    key = jax.random.key(seed)
    ks = iter(jax.random.split(key, 48))
    nrm = lambda shape, s=1.0: jax.random.normal(next(ks), shape, F32) * s
    W_B = min(BAND_PAST, PAST_LEN)
    u_lam = jax.random.uniform(next(ks), (N_C, R_WIDTH), F32, 0.9, 0.999) ** (1.0 / LRU_C)
    return {
        'x_prompt': nrm((BATCH, SEQ, D_MODEL)),
        'x_sample': nrm((DEC_BATCH, DEC_SEQ, D_MODEL)),
        'state_a_C': nrm((N_AB, DEC_BATCH, H_A, DH_A, DH_A), 0.1),
        'state_a_n': nrm((N_AB, DEC_BATCH, H_A, DH_A), 0.1),
        'state_a_m': nrm((N_AB, DEC_BATCH, H_A)),
        'cache_b_k': nrm((N_AB, DEC_BATCH, W_B, H_B, DH_B)),
        'cache_b_v': nrm((N_AB, DEC_BATCH, W_B, H_B, DH_B)),
        'state_c_conv': nrm((N_C, DEC_BATCH, CONV_W - 1, R_WIDTH)),
        'state_c_h': nrm((N_C, DEC_BATCH, R_WIDTH), 0.5),
        'c_prompt': nrm((BATCH, D_MODEL)),
        'c_sample': nrm((DEC_BATCH, D_MODEL)),
        'ffn1_norm': 1.0 + nrm((DEPTH, D_MODEL), 0.01),
        'ffn1_w_in': nrm((DEPTH, D_MODEL, 2 * D_FF), D_MODEL ** -0.5),
        'ffn1_w_out': nrm((DEPTH, D_FF, D_MODEL), D_FF ** -0.5),
        'mix_norm': 1.0 + nrm((DEPTH, D_MODEL), 0.01),
        'ffn2_norm': 1.0 + nrm((DEPTH, D_MODEL), 0.01),
        'ffn2_w_in': nrm((DEPTH, D_MODEL, 2 * D_FF), D_MODEL ** -0.5),
        'ffn2_w_out': nrm((DEPTH, D_FF, D_MODEL), D_FF ** -0.5),
        'ada_w': nrm((DEPTH, D_MODEL, N_ADA * D_MODEL), 0.5 * D_MODEL ** -0.5),
        'ada_b': nrm((DEPTH, N_ADA * D_MODEL), 0.01),
        'ab_w_in': nrm((N_AB, D_MODEL, PROJ_AB), D_MODEL ** -0.5),
        'ab_gate_bias': jnp.concatenate([nrm((N_AB, H_A), 0.1), 3.0 + nrm((N_AB, H_A), 0.5)], axis=-1),
        'a_out_norm': 1.0 + nrm((N_AB, H_A, DH_A), 0.01),
        'b_q_norm': 1.0 + nrm((N_AB, DH_B), 0.01),
        'b_k_norm': 1.0 + nrm((N_AB, DH_B), 0.01),
        'b_rel_bias': nrm((N_AB, H_B, 2 * MAX_REL + 1), 0.1),
        'ab_w_out': nrm((N_AB, D_MIX, D_MODEL), D_MIX ** -0.5),
        'c_w_in': nrm((N_C, D_MODEL, 2 * R_WIDTH), D_MODEL ** -0.5),
        'c_conv_w': nrm((N_C, CONV_W, R_WIDTH), CONV_W ** -0.5),
        'c_conv_b': nrm((N_C, R_WIDTH), 0.01),
        'c_gate_w': nrm((N_C, N_BLOCKS_C, BW_C, 2 * BW_C), BW_C ** -0.5),
        'c_gate_b': nrm((N_C, 2, R_WIDTH), 0.01),
        'c_lambda': jnp.log(u_lam) - jnp.log1p(-u_lam),
        'c_w_out': nrm((N_C, R_WIDTH, D_MODEL), R_WIDTH ** -0.5),
    }


def reference(x_prompt, x_sample, state_a_C, state_a_n, state_a_m, cache_b_k, cache_b_v,
              state_c_conv, state_c_h, c_prompt, c_sample,
              ffn1_norm, ffn1_w_in, ffn1_w_out, mix_norm, ffn2_norm, ffn2_w_in, ffn2_w_out,
              ada_w, ada_b, ab_w_in, ab_gate_bias, a_out_norm, b_q_norm, b_k_norm, b_rel_bias,
              ab_w_out, c_w_in, c_conv_w, c_conv_b, c_gate_w, c_gate_b, c_lambda, c_w_out):
    p = dict(ffn1_norm=ffn1_norm, ffn1_w_in=ffn1_w_in, ffn1_w_out=ffn1_w_out, mix_norm=mix_norm,
             ffn2_norm=ffn2_norm, ffn2_w_in=ffn2_w_in, ffn2_w_out=ffn2_w_out, ada_w=ada_w, ada_b=ada_b,
             ab_w_in=ab_w_in, ab_gate_bias=ab_gate_bias, a_out_norm=a_out_norm, b_q_norm=b_q_norm,
             b_k_norm=b_k_norm, b_rel_bias=b_rel_bias, ab_w_out=ab_w_out, c_w_in=c_w_in,
             c_conv_w=c_conv_w, c_conv_b=c_conv_b, c_gate_w=c_gate_w, c_gate_b=c_gate_b,
             c_lambda=c_lambda, c_w_out=c_w_out)
    y_prompt, ps = run_trunk(x_prompt, c_prompt, p, None)
    st = dict(a_C=state_a_C, a_n=state_a_n, a_m=state_a_m, b_k=cache_b_k, b_v=cache_b_v,
              c_conv=state_c_conv, c_h=state_c_h)
    y_sample, ss = run_trunk(x_sample, c_sample, p, st)
    return (y_prompt, y_sample,
            ps['a_C'], ps['a_n'], ps['a_m'], ps['b_k'], ps['b_v'], ps['c_conv'], ps['c_h'],
            ss['a_C'], ss['a_n'], ss['a_m'], ss['b_k'], ss['b_v'], ss['c_conv'], ss['c_h'])
```

```cpp
#include <hip/hip_runtime.h>
#include <cstdio>
#include <cstdint>
namespace pg8 {
#define PG8_LAS __attribute__((address_space(3)))
typedef unsigned short bf16_t;
typedef short bf16x8 __attribute__((ext_vector_type(8)));
typedef float f32x4 __attribute__((ext_vector_type(4)));
typedef unsigned u32x4 __attribute__((ext_vector_type(4)));
constexpr int BM = 256, BK = 64, HALF = 128, HTB = HALF * BK * 2  , STAGE_BYTES = 8 * HTB, NXCD = 8, WGM = 8;

__host__ __device__ __forceinline__ int lds_byte(int r, int c) { const int st = (r >> 4) * 2 + (c >> 5), rr = r & 15, cc = c & 31, ob = rr * 64 + cc * 2; return st * 1024 + (ob ^ (((ob >> 9) & 1) << 5)); }
__host__ __device__ __forceinline__ void stage_rc(int b, int& R, int& C) { const int st = b / 1024, sb = b % 1024, swz = sb ^ (((sb >> 9) & 1) << 5); R = (st >> 1) * 16 + swz / 64; C = (st & 1) * 32 + (swz % 64) / 2; }
__host__ __device__ __forceinline__ int perm32(int rho) { const int n = rho >> 4, i = rho & 15; return 8 * (i >> 2) + 4 * n + (i & 3); }

struct Unit { int pm, pn; };
struct Gemm { const bf16_t* A; const bf16_t* Bt; int M, N, K; };

struct StaticOrder {
    int nM, nN, nwg, G, c;
    __host__ __device__ void init(int M, int N, int G_, int c_) { nM = M / BM; nN = N / BM; nwg = nM * nN; G = G_; c = c_; }
    __host__ __device__ bool next(int i, Unit& u) const {
        const long L = (long)i * G + c; if (L >= nwg) return false;
        int wgid = (int)L; { const int q = nwg / NXCD, r = nwg % NXCD, xcd = wgid % NXCD, off = wgid / NXCD; wgid = (xcd < r ? xcd * (q + 1) : r * (q + 1) + (xcd - r) * q) + off; }
        const int nig = WGM * nN, gid = wgid / nig, fm = gid * WGM, gsz = (nM - fm) < WGM ? (nM - fm) : WGM;
        u.pm = fm + ((wgid % nig) % gsz); u.pn = (wgid % nig) / gsz; return true;
    }
    __device__ __forceinline__ void a_ready(const Unit&) const {}
    __device__ __forceinline__ void done(const Unit&) const {}
};
__device__ __forceinline__ unsigned cvt_pk_bf16(float lo, float hi) { unsigned r; asm volatile("v_cvt_pk_bf16_f32 %0, %1, %2" : "=v"(r) : "v"(lo), "v"(hi)); return r; }
typedef float f32x2 __attribute__((ext_vector_type(2)));
constexpr int MPROWS = 16384;
__device__ __forceinline__ int bidx(int row) { return row < MPROWS ? (row >> 11) : 8 + ((row - MPROWS) >> 4); }
typedef __bf16 bf16x2_t __attribute__((ext_vector_type(2)));
__device__ __forceinline__ unsigned pk2(float lo, float hi) { f32x2 v = {lo, hi}; bf16x2_t b = __builtin_convertvector(v, bf16x2_t); return __builtin_bit_cast(unsigned, b); }
__device__ __forceinline__ float fast_sigmoid(float x) { return __builtin_amdgcn_rcpf(1.0f + __builtin_amdgcn_exp2f(-1.44269504f * x)); }

struct EpiSwiglu {
    static constexpr bool PERM = true, AFTER_DRAIN = false;
    bf16_t* H; int ldh;
    __device__ __forceinline__ void operator()(const f32x4 (&acc)[2][2][4][2], const Unit& u, int wr, int wc, int fr, int fq) const {
        const int row0 = u.pm * BM + wr * 64 + fr, col0 = u.pn * HALF + wc * 32 + 8 * fq;
#pragma unroll
        for (int ai = 0; ai < 2; ++ai)
#pragma unroll
            for (int m = 0; m < 4; ++m) { bf16_t* rowp = H + (size_t)(row0 + ai * HALF + m * 16) * ldh + col0;
                float h[8];
#pragma unroll
                for (int n = 0; n < 2; ++n)
#pragma unroll
                    for (int j = 0; j < 4; ++j) { const float g = acc[ai][0][m][n][j], up = acc[ai][1][m][n][j]; h[4 * n + j] = g * fast_sigmoid(g) * up; }
                u32x4 w; w.x = pk2(h[0], h[1]); w.y = pk2(h[2], h[3]); w.z = pk2(h[4], h[5]); w.w = pk2(h[6], h[7]);
                *(u32x4*)rowp = w; }
    }
};

struct EpiRes {
    static constexpr bool PERM = false, AFTER_DRAIN = false;
    const float* base_p; const float* base_s; float* out; const float* gate; float s;
    __device__ __forceinline__ void operator()(const f32x4 (&acc)[2][2][4][2], const Unit& u, int wr, int wc, int fr, int fq) const {
        const int row0 = u.pm * BM + wr * 64 + fr, col0 = u.pn * BM + wc * 32 + 4 * fq;
#pragma unroll
        for (int ai = 0; ai < 2; ++ai)
#pragma unroll
            for (int m = 0; m < 4; ++m) { const int row = row0 + ai * HALF + m * 16; const int b = bidx(row);
                const float* bp = (row < MPROWS ? base_p + (size_t)row * 1024 : base_s + (size_t)(row - MPROWS) * 1024) + col0;
                const float* gp = gate + (size_t)b * 9216 + col0; float* op = out + (size_t)row * 1024 + col0;
#pragma unroll
                for (int bj = 0; bj < 2; ++bj)
#pragma unroll
                    for (int n = 0; n < 2; ++n) { const f32x4 bs = *(const f32x4*)(bp + bj * HALF + n * 16), gv = *(const f32x4*)(gp + bj * HALF + n * 16);
                        *(f32x4*)(op + bj * HALF + n * 16) = bs + (gv * s) * acc[ai][bj][m][n]; }
                asm volatile("" ::: "memory"); }
    }
};

struct EpiABin {
    static constexpr bool PERM = true, AFTER_DRAIN = false;
    bf16_t* U; size_t tstride; const float* qnw; const float* knw; float* pbk; float* pbv; float* sbk; float* sbv; float eps;
    __device__ __forceinline__ void operator()(const f32x4 (&acc)[2][2][4][2], const Unit& u, int wr, int wc, int fr, int fq) const {
        const int t = u.pn >> 1, half = u.pn & 1;
        bf16_t* dst = U + (size_t)t * tstride;
        const int row0 = u.pm * BM + wr * 64 + fr, lc0 = 256 * half + 64 * wc + 8 * fq;
        const bool norm = (t == 4 || t == 5);
        f32x4 nw[2][2];
        if (norm) { const float* w = (t == 4) ? qnw : knw;
#pragma unroll
            for (int bj = 0; bj < 2; ++bj)
#pragma unroll
                for (int n = 0; n < 2; ++n) nw[bj][n] = *(const f32x4*)(w + 32 * bj + 8 * fq + 4 * n); }
        const bool is_s = u.pm >= 64, is_ptail = (!is_s) && ((u.pm & 7) >= 6);
        float* fo = nullptr;
        if (t == 5) fo = is_s ? sbk : (is_ptail ? pbk : nullptr);
        if (t == 6) fo = is_s ? sbv : (is_ptail ? pbv : nullptr);
#pragma unroll
        for (int ai = 0; ai < 2; ++ai)
#pragma unroll
            for (int m = 0; m < 4; ++m) { const int row = row0 + ai * HALF + m * 16;
                f32x4 v[2][2];
#pragma unroll
                for (int bj = 0; bj < 2; ++bj)
#pragma unroll
                    for (int n = 0; n < 2; ++n) v[bj][n] = acc[ai][bj][m][n];
                if (norm) { float ss = 0.f;
#pragma unroll
                    for (int bj = 0; bj < 2; ++bj)
#pragma unroll
                        for (int n = 0; n < 2; ++n) ss += (v[bj][n][0] * v[bj][n][0] + v[bj][n][1] * v[bj][n][1]) + (v[bj][n][2] * v[bj][n][2] + v[bj][n][3] * v[bj][n][3]);
                    ss += __shfl_xor(ss, 16); ss += __shfl_xor(ss, 32);
                    const float rstd = 1.0f / sqrtf(ss * (1.0f / 64.0f) + eps);
#pragma unroll
                    for (int bj = 0; bj < 2; ++bj)
#pragma unroll
                        for (int n = 0; n < 2; ++n) v[bj][n] = v[bj][n] * rstd * nw[bj][n]; }
                bf16_t* rowp = dst + (size_t)row * 512 + lc0;
#pragma unroll
                for (int bj = 0; bj < 2; ++bj) { u32x4 w; w.x = pk2(v[bj][0][0], v[bj][0][1]); w.y = pk2(v[bj][0][2], v[bj][0][3]); w.z = pk2(v[bj][1][0], v[bj][1][1]); w.w = pk2(v[bj][1][2], v[bj][1][3]);
                    *(u32x4*)(rowp + 32 * bj) = w; }
                if (fo) { size_t orow;
                    if (is_s) orow = (size_t)(row - MPROWS); else orow = (size_t)(row >> 11) * 512 + (size_t)((row & 2047) - 1536);
                    float* op = fo + orow * 512 + lc0;
#pragma unroll
                    for (int bj = 0; bj < 2; ++bj)
#pragma unroll
                        for (int n = 0; n < 2; ++n) *(f32x4*)(op + 32 * bj + 4 * n) = v[bj][n]; }
            }
    }
};

struct EpiCin {
    static constexpr bool PERM = true, AFTER_DRAIN = false;
    bf16_t* GB; bf16_t* XB; float* pcc; float* scc;
    __device__ __forceinline__ void operator()(const f32x4 (&acc)[2][2][4][2], const Unit& u, int wr, int wc, int fr, int fq) const {
        const bool isx = u.pn >= 4; bf16_t* dst = isx ? XB : GB;
        const int row0 = u.pm * BM + wr * 64 + fr, col0 = 256 * (u.pn & 3) + wc * 32 + 8 * fq;
        const bool is_s = u.pm >= 64;
#pragma unroll
        for (int ai = 0; ai < 2; ++ai)
#pragma unroll
            for (int m = 0; m < 4; ++m) { const int row = row0 + ai * HALF + m * 16; bf16_t* rowp = dst + (size_t)row * 1024 + col0;
#pragma unroll
                for (int bj = 0; bj < 2; ++bj) { const f32x4 v0 = acc[ai][bj][m][0], v1 = acc[ai][bj][m][1];
                    u32x4 w; w.x = pk2(v0[0], v0[1]); w.y = pk2(v0[2], v0[3]); w.z = pk2(v1[0], v1[1]); w.w = pk2(v1[2], v1[3]);
                    *(u32x4*)(rowp + bj * HALF) = w; }
                if (isx) { float* op = nullptr;
                    if (is_s) { const int r = row - MPROWS, tt = r & 15; if (tt >= 13) op = scc + ((size_t)(r >> 4) * 3 + (tt - 13)) * 1024 + col0; }
                    else { const int tt = row & 2047; if (tt >= 2045) op = pcc + ((size_t)(row >> 11) * 3 + (tt - 2045)) * 1024 + col0; }
                    if (op) {
#pragma unroll
                        for (int bj = 0; bj < 2; ++bj)
#pragma unroll
                            for (int n = 0; n < 2; ++n) *(f32x4*)(op + bj * HALF + 4 * n) = acc[ai][bj][m][n]; } }
            }
    }
};
template <class Epi, class Sched, bool ALIGN_EPI = false, bool SP2 = false>
__device__ __forceinline__ void gemm_phase(PG8_LAS unsigned char* lds, const Gemm g, const Sched& S, const Epi& E, const int tid) {
    const int wid = __builtin_amdgcn_readfirstlane(tid >> 6), lane = tid & 63, wr = wid >> 2, wc = wid & 3, fr = lane & 15, fq = lane >> 4;
    const int K = g.K, nt = K / BK;
    unsigned voffA[2], voffB[2];
#pragma unroll
    for (int i = 0; i < 2; ++i) { int R, C; stage_rc(tid * 16 + i * 8192, R, C); const int Rb = Epi::PERM ? ((R & ~31) + perm32(R & 31)) : R;
        voffA[i] = (unsigned)(R * K + C) * 2u; voffB[i] = (unsigned)(Rb * K + C) * 2u; }
    const size_t kstep = (size_t)(BK * 2);
    const size_t hstep = (size_t)HALF * K * 2;
    const size_t tstep = 2 * hstep;
    const unsigned ldsw = (unsigned)wid * 1024u;
    const int aoff = lds_byte(wr * 64 + fr, fq * 8), boff = lds_byte(wc * 32 + fr, fq * 8);
#define PG8_SA(b, h) (((b) * 2 + (h)) * HTB)
#define PG8_SB(b, h) ((4 + (b) * 2 + (h)) * HTB)
#define PG8_STAGE(bufoff, gbase, voff) do { _Pragma("unroll") for (int _i = 0; _i < 2; ++_i) \
        __builtin_amdgcn_global_load_lds((const unsigned*)((const char*)(gbase) + (voff)[_i]), (PG8_LAS unsigned*)(lds + (bufoff) + ldsw + _i * 8192), 16, 0, 0); } while (0)
#define PG8_LDA(dst, b, h) do { _Pragma("unroll") for (int m = 0; m < 4; ++m) _Pragma("unroll") for (int k = 0; k < 2; ++k) dst[m][k] = *(const PG8_LAS bf16x8*)(lds + PG8_SA(b, h) + aoff + m * 2048 + k * 1024); } while (0)
#define PG8_LDB(dst, b, h) do { _Pragma("unroll") for (int n = 0; n < 2; ++n) _Pragma("unroll") for (int k = 0; k < 2; ++k) dst[n][k] = *(const PG8_LAS bf16x8*)(lds + PG8_SB(b, h) + boff + n * 2048 + k * 1024); } while (0)
#define PG8_MMA(ai, bj, At, Bt) do { __builtin_amdgcn_s_setprio(1); _Pragma("unroll") for (int m = 0; m < 4; ++m) _Pragma("unroll") for (int n = 0; n < 2; ++n) _Pragma("unroll") for (int k = 0; k < 2; ++k) \
        acc[ai][bj][m][n] = __builtin_amdgcn_mfma_f32_16x16x32_bf16(Bt[n][k], At[m][k], acc[ai][bj][m][n], 0, 0, 0); __builtin_amdgcn_s_setprio(0); } while (0)
#define PG8_WAIT_V(n) asm volatile("s_waitcnt vmcnt(" #n ")" ::: "memory")
#define PG8_WAIT_L(n) asm volatile("s_waitcnt lgkmcnt(" #n ")" ::: "memory")
#define PG8_BAR __builtin_amdgcn_s_barrier()
#define PG8_SCHED __builtin_amdgcn_sched_barrier(0)
    Unit cur, nxt; int ui = 0;
    if (!S.next(0, cur)) return;
    f32x4 acc[2][2][4][2];
#pragma unroll
    for (int a = 0; a < 2; ++a)
#pragma unroll
        for (int b = 0; b < 2; ++b)
#pragma unroll
            for (int m = 0; m < 4; ++m)
#pragma unroll
                for (int n = 0; n < 2; ++n) acc[a][b][m][n] = (f32x4){0.f, 0.f, 0.f, 0.f};
    bf16x8 At[4][2], B0[2][2], B1[2][2];
    const char* cA = (const char*)g.A + (size_t)cur.pm * tstep; const char* cB = (const char*)g.Bt + (size_t)cur.pn * tstep;
    S.a_ready(cur);
    if constexpr (SP2) {
        PG8_STAGE(PG8_SB(0, 0), cB, voffB); PG8_STAGE(PG8_SB(0, 1), cB + hstep, voffB); PG8_STAGE(PG8_SA(0, 0), cA, voffA); PG8_STAGE(PG8_SA(0, 1), cA + hstep, voffA);
        if (wr == 1) PG8_BAR;
        PG8_WAIT_V(2); PG8_BAR;
        PG8_STAGE(PG8_SB(1, 0), cB + kstep, voffB); PG8_STAGE(PG8_SA(1, 0), cA + kstep, voffA); PG8_STAGE(PG8_SB(1, 1), cB + hstep + kstep, voffB);
        PG8_WAIT_V(6); PG8_BAR;
    } else {
        PG8_STAGE(PG8_SB(0, 0), cB, voffB); PG8_STAGE(PG8_SA(0, 0), cA, voffA); PG8_STAGE(PG8_SB(0, 1), cB + hstep, voffB); PG8_STAGE(PG8_SA(0, 1), cA + hstep, voffA);
        if (wr == 1) PG8_BAR;
        PG8_WAIT_V(4); PG8_BAR;
        PG8_STAGE(PG8_SB(1, 0), cB + kstep, voffB); PG8_STAGE(PG8_SA(1, 0), cA + kstep, voffA); PG8_STAGE(PG8_SB(1, 1), cB + hstep + kstep, voffB);
        PG8_WAIT_V(6); PG8_BAR;
    }
    for (;;) {
        const bool has_next = S.next(ui + 1, nxt);
        const char* nA = has_next ? (const char*)g.A + (size_t)nxt.pm * tstep : cA; const char* nB = has_next ? (const char*)g.Bt + (size_t)nxt.pn * tstep : cB;
        for (int t = 0; t < nt; t += 2) {
            const bool last = (t == nt - 2);
            const char* a1 = cA + (size_t)(t + 1) * kstep;
            const char* a2 = last ? nA : cA + (size_t)(t + 2) * kstep; const char* b2 = last ? nB : cB + (size_t)(t + 2) * kstep;
            const char* a3 = a2 + kstep; const char* b3 = b2 + kstep;
            if (last && has_next) S.a_ready(nxt);
            if constexpr (SP2) {
            PG8_LDB(B0, 0, 0); PG8_LDB(B1, 0, 1); PG8_SCHED; PG8_LDA(At, 0, 0); PG8_STAGE(PG8_SA(1, 1), a1 + hstep, voffA);
            PG8_WAIT_V(8); PG8_WAIT_L(0); PG8_BAR; PG8_MMA(0, 0, At, B0); PG8_MMA(0, 1, At, B1); PG8_BAR; PG8_SCHED;
            PG8_LDA(At, 0, 1); PG8_STAGE(PG8_SB(0, 0), b2, voffB); PG8_STAGE(PG8_SB(0, 1), b2 + hstep, voffB); PG8_STAGE(PG8_SA(0, 0), a2, voffA);
            PG8_WAIT_V(8); PG8_WAIT_L(0); PG8_BAR; PG8_MMA(1, 0, At, B0); PG8_MMA(1, 1, At, B1); PG8_BAR; PG8_SCHED;
            PG8_LDB(B0, 1, 0); PG8_LDB(B1, 1, 1); PG8_SCHED; PG8_LDA(At, 1, 0); PG8_STAGE(PG8_SA(0, 1), a2 + hstep, voffA);
            PG8_WAIT_V(8); PG8_WAIT_L(0); PG8_BAR; PG8_MMA(0, 0, At, B0); PG8_MMA(0, 1, At, B1); PG8_BAR; PG8_SCHED;
            PG8_LDA(At, 1, 1); PG8_STAGE(PG8_SB(1, 0), b3, voffB); PG8_STAGE(PG8_SB(1, 1), b3 + hstep, voffB); PG8_STAGE(PG8_SA(1, 0), a3, voffA);
            PG8_WAIT_V(8); PG8_WAIT_L(0); PG8_BAR; PG8_MMA(1, 0, At, B0); PG8_MMA(1, 1, At, B1); PG8_BAR; PG8_SCHED;
            } else {
            PG8_LDB(B0, 0, 0); PG8_SCHED; PG8_LDA(At, 0, 0); PG8_STAGE(PG8_SA(1, 1), a1 + hstep, voffA);
            PG8_WAIT_L(8); PG8_BAR; PG8_WAIT_L(0); PG8_MMA(0, 0, At, B0); PG8_BAR; PG8_SCHED;
            PG8_LDB(B1, 0, 1); PG8_STAGE(PG8_SB(0, 0), b2, voffB);
            PG8_BAR; PG8_WAIT_L(0); PG8_MMA(0, 1, At, B1); PG8_BAR;
            PG8_LDA(At, 0, 1); PG8_STAGE(PG8_SA(0, 0), a2, voffA);
            PG8_BAR; PG8_WAIT_L(0); PG8_MMA(1, 0, At, B0); PG8_BAR; PG8_SCHED;
            PG8_STAGE(PG8_SB(0, 1), b2 + hstep, voffB);
            PG8_WAIT_V(6); PG8_BAR; PG8_MMA(1, 1, At, B1); PG8_BAR;
            PG8_LDB(B0, 1, 0); PG8_SCHED; PG8_LDA(At, 1, 0); PG8_STAGE(PG8_SA(0, 1), a2 + hstep, voffA);
            PG8_WAIT_L(8); PG8_BAR; PG8_WAIT_L(0); PG8_MMA(0, 0, At, B0); PG8_BAR; PG8_SCHED;
            PG8_LDB(B1, 1, 1); PG8_STAGE(PG8_SB(1, 0), b3, voffB);
            PG8_BAR; PG8_WAIT_L(0); PG8_MMA(0, 1, At, B1); PG8_BAR;
            PG8_LDA(At, 1, 1); PG8_STAGE(PG8_SA(1, 0), a3, voffA);
            PG8_BAR; PG8_WAIT_L(0); PG8_MMA(1, 0, At, B0); PG8_BAR; PG8_SCHED;
            PG8_STAGE(PG8_SB(1, 1), b3 + hstep, voffB);
            PG8_WAIT_V(6); PG8_BAR; PG8_MMA(1, 1, At, B1); PG8_BAR;
            }
        }
        if constexpr (ALIGN_EPI) { if (wr == 0) PG8_BAR; }
        if constexpr (!Epi::AFTER_DRAIN) { E(acc, cur, wr, wc, fr, fq); S.done(cur); }
        if (!has_next) break;
#pragma unroll
        for (int a = 0; a < 2; ++a)
#pragma unroll
            for (int b = 0; b < 2; ++b)
#pragma unroll
                for (int m = 0; m < 4; ++m)
#pragma unroll
                    for (int n = 0; n < 2; ++n) acc[a][b][m][n] = (f32x4){0.f, 0.f, 0.f, 0.f};
        cur = nxt; cA = nA; cB = nB; ++ui;
        if constexpr (ALIGN_EPI) { if (wr == 1) PG8_BAR; }
    }
    PG8_WAIT_V(0);
    if constexpr (!ALIGN_EPI) { if (wr == 0) PG8_BAR; }
    PG8_BAR;
    if constexpr (Epi::AFTER_DRAIN) { E.fused(acc, cur, wr, wc, fr, fq, lds, wid, lane); S.done(cur); }
#undef PG8_SA
#undef PG8_SB
#undef PG8_STAGE
#undef PG8_LDA
#undef PG8_LDB
#undef PG8_MMA
#undef PG8_WAIT_V
#undef PG8_WAIT_L
#undef PG8_BAR
#undef PG8_SCHED
}
}
#define GAS __attribute__((address_space(1)))
#define LAS __attribute__((address_space(3)))
typedef unsigned short bf16;
typedef unsigned v4u __attribute__((ext_vector_type(4)));
typedef float f32x4 __attribute__((ext_vector_type(4)));
typedef short bf16x8 __attribute__((ext_vector_type(8)));
typedef GAS unsigned gu32;
typedef GAS unsigned long long gu64;
#define RLX_AGENT __ATOMIC_RELAXED, __HIP_MEMORY_SCOPE_AGENT
#define LDS_WAIT() asm volatile("s_waitcnt lgkmcnt(0)" ::: "memory")
#define VM_WAIT() asm volatile("s_waitcnt vmcnt(0)" ::: "memory")
__device__ __forceinline__ unsigned long long rt() { return __builtin_amdgcn_s_memrealtime(); }

#define XB_TMO      128
#define XB_XCNT(j)  (256  + 64 * (j))
#define XB_XSUB(j)  (1280 + 64 * (j))
#define XB_XGEN(j)  (2304 + 64 * (j))
#define XB_TOP      3328
#define XB_TOPGEN   3392
#define XCD_BAR_WORDS 3456
#define XB_SPIN_CAP (1u << 18)

__device__ __forceinline__ unsigned xb_ld(unsigned* p)              { return __hip_atomic_load(p, __ATOMIC_RELAXED, __HIP_MEMORY_SCOPE_AGENT); }
__device__ __forceinline__ unsigned xb_add(unsigned* p, unsigned v) { return __hip_atomic_fetch_add(p, v, __ATOMIC_RELAXED, __HIP_MEMORY_SCOPE_AGENT); }
__device__ __forceinline__ unsigned xb_xcc_id() { return (unsigned)__builtin_amdgcn_s_getreg((3 << 11) | 20) & 0xFu; }
#define XB_SPIN(cond, bar) do { unsigned _sp = 0; while (cond) { __builtin_amdgcn_s_sleep(1); \
    if ((++_sp & 255u) == 0u) { if (xb_ld(&(bar)[XB_TMO])) break; if (_sp > XB_SPIN_CAP) { atomicAdd(&(bar)[XB_TMO], 1u); break; } } } } while (0)

struct XcdBarrier {
    unsigned* bar; unsigned x;
    volatile LAS unsigned* st;
};

__device__ __forceinline__ XcdBarrier xcd_barrier_post(unsigned* bar, volatile LAS unsigned* st) {
    XcdBarrier b; b.bar = bar; b.x = xb_xcc_id(); b.st = st;
    if (threadIdx.x == 0) (void)xb_add(&bar[XB_XCNT(b.x)], 1u);
    return b;
}
__device__ __forceinline__ void xcd_barrier_complete(unsigned* bar, unsigned x, unsigned& nloc, unsigned& nx) {
    const unsigned G = gridDim.x * gridDim.y * gridDim.z;
    unsigned sum, cnt, mine, sp = 0u;
    for (;;) {
        sum = 0u; cnt = 0u; mine = 0u;
#pragma unroll
        for (unsigned j = 0; j < 16; ++j) { const unsigned c = xb_ld(&bar[XB_XCNT(j)]); sum += c; cnt += (c > 0u) ? 1u : 0u; mine = (j == x) ? c : mine; }
        if (sum == G) break;
        __builtin_amdgcn_s_sleep(1);
        if ((++sp & 255u) == 0u) { if (xb_ld(&bar[XB_TMO])) break; if (sp > XB_SPIN_CAP) { atomicAdd(&bar[XB_TMO], 1u); break; } }
    }
    nloc = mine > 0u ? mine : 1u; nx = cnt > 0u ? cnt : 1u;
}

__device__ __forceinline__ void xcd_barrier(const XcdBarrier& b) {
    asm volatile("s_waitcnt vmcnt(0)" ::: "memory");
    __syncthreads();
    if (threadIdx.x == 0) {
        unsigned* bar = b.bar;
        __builtin_amdgcn_s_waitcnt(0);
        unsigned nloc = b.st[0], nx = b.st[1];
        if (nloc == 0u) { xcd_barrier_complete(bar, b.x, nloc, nx); b.st[0] = nloc; b.st[1] = nx; }
        const unsigned old = xb_add(&bar[XB_XSUB(b.x)], 1u);
        const unsigned gen = old / nloc;
        if (old + 1u == (gen + 1u) * nloc) {
            __builtin_amdgcn_fence(__ATOMIC_RELEASE, "agent");
            asm volatile("s_waitcnt vmcnt(0)" ::: "memory");
            const unsigned og = xb_add(&bar[XB_TOP], 1u);
            const unsigned tg = og / nx;
            if (og + 1u == (tg + 1u) * nx) xb_add(&bar[XB_TOPGEN], 1u);
            else XB_SPIN(xb_ld(&bar[XB_TOPGEN]) == tg, bar);
            __builtin_amdgcn_fence(__ATOMIC_ACQUIRE, "agent");
            xb_add(&bar[XB_XGEN(b.x)], 1u);
            asm volatile("s_waitcnt vmcnt(0)" ::: "memory");
        } else {
            XB_SPIN(xb_ld(&bar[XB_XGEN(b.x)]) == gen, bar);
            __builtin_amdgcn_fence(__ATOMIC_ACQUIRE, "agent");
            asm volatile("s_waitcnt vmcnt(0)" ::: "memory");
        }
    }
    __syncthreads();
}
constexpr int NWAVES = 8;
constexpr int MP = 16384, MS = 512, MT = 16896, D = 1024, DFF = 2816, NADA = 9216, NBR = 40;
constexpr float EPS = 1e-6f;
constexpr size_t MiB = 1u << 20;
constexpr size_t WS_CTL = 0, CTL_ZERO_BYTES = 1 * MiB;
constexpr size_t WS_ADAP = 1 * MiB;
constexpr size_t WS_ADA = 24 * MiB;
constexpr size_t WS_GA = 27 * MiB;
constexpr size_t WS_CARRY = 28 * MiB;
constexpr size_t WS_WFIN = 32 * MiB;
constexpr size_t WS_WFOUT = 76 * MiB;
constexpr size_t WS_WABIN = 98 * MiB;
constexpr size_t WS_WABOUT = 105 * MiB;
constexpr size_t WS_WCIN = 107 * MiB;
constexpr size_t WS_WCOUT = 111 * MiB;
constexpr size_t WS_WGATE = 113 * MiB;
constexpr size_t WS_XN = 114 * MiB;
constexpr size_t WS_BIG = 147 * MiB;
constexpr size_t WS_END = 263 * MiB;
constexpr size_t FIN_ELEMS = (size_t)5632 * 1024, FOUT_ELEMS = (size_t)1024 * 2816, U_ELEMS = (size_t)MT * 512;
constexpr int CW_BAR = 4096;
constexpr size_t O_YP = 0, O_YS = 16777216, O_PAC = 17301504, O_PAN = 17825792, O_PAM = 17829888, O_PBK = 17829920, O_PBV = 19927072, O_PCC = 22024224, O_PCH = 22048800,
                 O_SAC = 22056992, O_SAN = 24154144, O_SAM = 24170528, O_SBK = 24170656, O_SBV = 24432800, O_SCC = 24694944, O_SCH = 24793248, O_TOTAL = 24826016;
constexpr int RING_BYTES = 131072, LDSCTL_OFF = RING_BYTES, MISC_OFF = LDSCTL_OFF + 320, LDS_BYTES = 147456;

typedef short s16x4 __attribute__((ext_vector_type(4)));
typedef unsigned u32x2 __attribute__((ext_vector_type(2)));
using pg8::pk2; using pg8::bidx; using pg8::fast_sigmoid;
__device__ __forceinline__ float bf2f(unsigned short u) { return __uint_as_float(((unsigned)u) << 16); }
__device__ __forceinline__ float bflo(unsigned w) { return __uint_as_float(w << 16); }
__device__ __forceinline__ float bfhi(unsigned w) { return __uint_as_float(w & 0xffff0000u); }
__device__ __forceinline__ float wave_sum(float v) {
#pragma unroll
    for (int o = 1; o < 64; o <<= 1) v += __shfl_xor(v, o);
    return v; }
__device__ __forceinline__ float wave_max(float v) {
#pragma unroll
    for (int o = 1; o < 64; o <<= 1) v = fmaxf(v, __shfl_xor(v, o));
    return v; }
__device__ __forceinline__ f32x4 mfma16(bf16x8 a, bf16x8 b, f32x4 c) { return __builtin_amdgcn_mfma_f32_16x16x32_bf16(a, b, c, 0, 0, 0); }
typedef short v4i16_t __attribute__((ext_vector_type(4)));
__device__ __forceinline__ s16x4 ldtr(const LAS unsigned short* p) { return __builtin_bit_cast(s16x4, __builtin_amdgcn_ds_read_tr16_b64_v4i16((LAS v4i16_t*)p)); }
__device__ __forceinline__ bf16x8 cat8(s16x4 a, s16x4 b) { return (bf16x8){a[0], a[1], a[2], a[3], b[0], b[1], b[2], b[3]}; }

__device__ __forceinline__ void p0_ada_item(const float* cP, const float* cS, const float* adaw, float* part, LAS float* cs, int item, int tid) {
    const int cb = item % 18, ks = item / 18, l = cb / 9, n = (cb % 9) * 1024 + tid * 2, k0 = ks * 128;
    for (int idx = tid; idx < 128 * NBR; idx += 512) { const int b = idx >> 7, kk = idx & 127; const float* c = b < 8 ? cP + b * 1024 : cS + (b - 8) * 1024; cs[kk * NBR + b] = c[k0 + kk]; }
    __syncthreads();
    float ax[NBR], ay[NBR];
#pragma unroll
    for (int b = 0; b < NBR; ++b) { ax[b] = 0.f; ay[b] = 0.f; }
    const float* wp = adaw + ((size_t)l * 1024 + k0) * NADA + n;
#pragma unroll 2
    for (int kk = 0; kk < 128; ++kk) { const float2 w = *(const float2*)(wp + (size_t)kk * NADA); const LAS f32x4* c4 = (const LAS f32x4*)(cs + kk * NBR);
#pragma unroll
        for (int b4 = 0; b4 < NBR / 4; ++b4) { const f32x4 cv = c4[b4];
#pragma unroll
            for (int e = 0; e < 4; ++e) { ax[4 * b4 + e] += cv[e] * w.x; ay[4 * b4 + e] += cv[e] * w.y; } } }
    float* pp = part + ((size_t)(ks * 2 + l) * NBR) * NADA + n;
#pragma unroll
    for (int b = 0; b < NBR; ++b) *(float2*)(pp + (size_t)b * NADA) = make_float2(ax[b], ay[b]);
    __syncthreads();
}
__device__ __forceinline__ void tr_item(const float* W, int ldw, int c0, int k0, unsigned short* WT, int r0, int Kd, LAS float* scr, int lane) {
#pragma unroll 8
    for (int i = 0; i < 32; ++i) { const int kk = 2 * i + (lane >> 5); scr[kk * 33 + (lane & 31)] = W[(size_t)(k0 + kk) * ldw + c0 + (lane & 31)]; }
    LDS_WAIT(); asm volatile("" ::: "memory");
    const int c = lane & 7;
#pragma unroll
    for (int j = 0; j < 4; ++j) { const int n = (lane >> 3) + 8 * j; const LAS float* s = scr + (8 * c) * 33 + n;
        v4u o; o.x = pk2(s[0 * 33], s[1 * 33]); o.y = pk2(s[2 * 33], s[3 * 33]); o.z = pk2(s[4 * 33], s[5 * 33]); o.w = pk2(s[6 * 33], s[7 * 33]);
        *(GAS v4u*)(WT + (size_t)(r0 + n) * Kd + k0 + 8 * c) = o; }
    LDS_WAIT(); asm volatile("" ::: "memory");
}
struct Args { const float* in[34]; float* out; unsigned char* ws; };
struct Ctx { float* out; unsigned char* ws; };
__device__ __forceinline__ const float* inptr(int i) {
    const float* const __attribute__((address_space(4)))* p = (const float* const __attribute__((address_space(4)))*)__builtin_amdgcn_kernarg_segment_ptr();
    asm volatile("" : "+s"(p));
    return p[i]; }

__device__ __forceinline__ void p0_weights(const Ctx& A, LAS float* scr, int gw, int NGW, int lane) {
    unsigned char* ws = A.ws;
    constexpr int I_FIN = 16 * 176, I_FOUT = 44 * 32, I_ABIN = 16 * 112, I_SQ = 16 * 32, I_CIN = 16 * 64, I_GATE = 8 * 16;
    constexpr int NITEMS = 4 * I_FIN + 4 * I_FOUT + I_ABIN + I_SQ + I_CIN + I_SQ + I_GATE;
    for (int it = gw; it < NITEMS; it += NGW) {
        int r = it;
        if (r < 4 * I_FIN) { const int f = r / I_FIN; r -= f * I_FIN; const int kb = r / 176, nb = r % 176, n0 = 32 * nb;
            const float* W = inptr((f >> 1) ? 16 : 12) + (size_t)(f & 1) * 1024 * 5632;
            const int r0 = n0 < DFF ? 256 * (n0 >> 7) + (n0 & 127) : 256 * ((n0 - DFF) >> 7) + 128 + ((n0 - DFF) & 127);
            tr_item(W, 5632, n0, 64 * kb, (unsigned short*)(ws + WS_WFIN) + (size_t)f * FIN_ELEMS, r0, 1024, scr, lane); continue; }
        r -= 4 * I_FIN;
        if (r < 4 * I_FOUT) { const int f = r / I_FOUT; r -= f * I_FOUT; const int kb = r / 32, nb = r % 32;
            const float* W = inptr((f >> 1) ? 17 : 13) + (size_t)(f & 1) * DFF * 1024;
            tr_item(W, 1024, 32 * nb, 64 * kb, (unsigned short*)(ws + WS_WFOUT) + (size_t)f * FOUT_ELEMS, 32 * nb, DFF, scr, lane); continue; }
        r -= 4 * I_FOUT;
        if (r < I_ABIN) { const int kb = r / 112, nb = r % 112, L0 = 32 * nb, c0 = L0 < 2048 ? L0 : L0 + 8, l = L0 & 255;
            const int r0 = 256 * (L0 >> 8) + 128 * ((l >> 5) & 1) + 32 * (l >> 6);
            tr_item(inptr(20), 3592, c0, 64 * kb, (unsigned short*)(ws + WS_WABIN), r0, 1024, scr, lane); continue; }
        r -= I_ABIN;
        if (r < I_SQ) { tr_item(inptr(26), 1024, 32 * (r % 32), 64 * (r / 32), (unsigned short*)(ws + WS_WABOUT), 32 * (r % 32), 1024, scr, lane); continue; }
        r -= I_SQ;
        if (r < I_CIN) { tr_item(inptr(27), 2048, 32 * (r % 64), 64 * (r / 64), (unsigned short*)(ws + WS_WCIN), 32 * (r % 64), 1024, scr, lane); continue; }
        r -= I_CIN;
        if (r < I_SQ) { tr_item(inptr(33), 1024, 32 * (r % 32), 64 * (r / 32), (unsigned short*)(ws + WS_WCOUT), 32 * (r % 32), 1024, scr, lane); continue; }
        r -= I_SQ;
        { const int blk = r >> 4, kb = (r >> 3) & 1, nb = r & 7;
          tr_item(inptr(30) + (size_t)blk * 128 * 256, 256, 32 * nb, 64 * kb, (unsigned short*)(ws + WS_WGATE) + (size_t)blk * 256 * 128, 32 * nb, 128, scr, lane); }
    }
}

template <bool GATES>
__device__ __forceinline__ void norm_phase(const float* xp, const float* xs, const float* nw, const float* adaL, int j3, unsigned short* XN,
                                           const float* wg_src  , const float* gbias, float* GA, LAS float* wg, int gw, int NGW, int lane, int tid) {
    if (GATES) {
        for (int i = tid; i < 1024 * 8; i += 512) wg[i] = wg_src[(size_t)(i >> 3) * 3592 + 2048 + (i & 7)];
        __syncthreads();
    }
    for (int row = gw; row < MT; row += NGW) {
        const float* xr = row < MP ? xp + (size_t)row * D : xs + (size_t)(row - MP) * D;
        const int b = bidx(row); const float* sh = adaL + (size_t)b * NADA + j3 * 1024; const float* sc = sh + 1024;
        f32x4 v[4]; float ss = 0.f;
#pragma unroll
        for (int j = 0; j < 4; ++j) { v[j] = *(const f32x4*)(xr + j * 256 + lane * 4); ss += (v[j][0] * v[j][0] + v[j][1] * v[j][1]) + (v[j][2] * v[j][2] + v[j][3] * v[j][3]); }
        const float rstd = 1.0f / sqrtf(wave_sum(ss) * (1.0f / D) + EPS);
        float ga[8];
#pragma unroll
        for (int e = 0; e < 8; ++e) ga[e] = 0.f;
#pragma unroll
        for (int j = 0; j < 4; ++j) { const int col = j * 256 + lane * 4;
            const f32x4 g = *(const f32x4*)(nw + col), s1 = *(const f32x4*)(sc + col), s0 = *(const f32x4*)(sh + col);
            const f32x4 y = v[j] * rstd * g * (s1 + 1.0f) + s0;
            u32x2 o; o.x = pk2(y[0], y[1]); o.y = pk2(y[2], y[3]);
            *(u32x2*)(XN + (size_t)row * D + col) = o;
            if (GATES) {
#pragma unroll
                for (int e = 0; e < 4; ++e) { const f32x4 w0 = *(const LAS f32x4*)(wg + (col + e) * 8), w1 = *(const LAS f32x4*)(wg + (col + e) * 8 + 4);
                    ga[0] += y[e] * w0[0]; ga[1] += y[e] * w0[1]; ga[2] += y[e] * w0[2]; ga[3] += y[e] * w0[3];
                    ga[4] += y[e] * w1[0]; ga[5] += y[e] * w1[1]; ga[6] += y[e] * w1[2]; ga[7] += y[e] * w1[3]; } }
        }
        if (GATES) {
#pragma unroll
            for (int e = 0; e < 8; ++e) ga[e] = wave_sum(ga[e]);
            if (lane < 8) { float x = ga[0];
#pragma unroll
                for (int e = 1; e < 8; ++e) x = (lane == e) ? ga[e] : x;
                x += gbias[lane];
                if (lane >= 4) x = fminf(x, 0.f) - log1pf(expf(-fabsf(x)));
                GA[(size_t)row * 8 + lane] = x; }
        }
    }
}

constexpr int ML_Q = 0, ML_K = 17408, ML_V = 34816, ML_KW = 52224, ML_S = 69632, ML_CT = 78848, ML_TAB = 113664;
constexpr int MLP = 136, MSP = 72;
__device__ __forceinline__ float scan_add(float v, int lane) {
#pragma unroll
    for (int o = 1; o < 64; o <<= 1) { const float t = __shfl_up(v, o); if (lane >= o) v += t; }
    return v; }
__device__ __forceinline__ float scan_max(float v, int lane) {
#pragma unroll
    for (int o = 1; o < 64; o <<= 1) { const float t = __shfl_up(v, o); if (lane >= o) v = fmaxf(v, t); }
    return v; }

__device__ __forceinline__ void mlstm_seq(LAS unsigned char* lds, const unsigned short* QA, const unsigned short* KA, const unsigned short* VA, const unsigned short* OA, const float* GA,
                                          unsigned short* MIX, const float* gnorm, int rowbase, int h, int nchunk, int L,
                                          const float* C0, const float* n0, const float* m0p, float* Cout, float* nout, float* mout, int tid) {
    const int lane = tid & 63, w = __builtin_amdgcn_readfirstlane(tid >> 6), li = lane & 15, q = lane >> 4, qq = li >> 2, pp = li & 3;
    LAS unsigned short* Qs = (LAS unsigned short*)(lds + ML_Q); LAS unsigned short* Ks = (LAS unsigned short*)(lds + ML_K);
    LAS unsigned short* Vs = (LAS unsigned short*)(lds + ML_V); LAS unsigned short* Kws = (LAS unsigned short*)(lds + ML_KW);
    LAS unsigned short* Ss = (LAS unsigned short*)(lds + ML_S); LAS unsigned short* CT = (LAS unsigned short*)(lds + ML_CT);
    LAS float* nS = (LAS float*)(lds + ML_TAB); LAS float* qnS = nS + 128; LAS float* SpS = qnS + 64; LAS float* ssS = SpS + 256;
    __syncthreads();
    f32x4 accC[8];
#pragma unroll
    for (int i = 0; i < 8; ++i) {
#pragma unroll
        for (int r = 0; r < 4; ++r) accC[i][r] = C0 ? C0[(size_t)(16 * i + 4 * q + r) * 128 + 16 * w + li] : 0.f;
        u32x2 o; o.x = pk2(accC[i][0], accC[i][1]); o.y = pk2(accC[i][2], accC[i][3]);
        *(LAS u32x2*)(CT + (16 * w + li) * MLP + 16 * i + 4 * q) = o; }
    float m = m0p ? *m0p : 0.f;
    if (tid < 128) nS[tid] = n0 ? n0[tid] : 0.f;
    v4u pq[2], pk[2], pv[2];
    const v4u zero4 = {0u, 0u, 0u, 0u};
#pragma unroll
    for (int c2 = 0; c2 < 2; ++c2) { const int ci = tid + 512 * c2, r = ci >> 4, c16 = ci & 15; const size_t off = (size_t)(rowbase + r) * 512 + h * 128 + 8 * c16;
        if (r < L) { pq[c2] = *(const v4u*)(QA + off); pk[c2] = *(const v4u*)(KA + off); pv[c2] = *(const v4u*)(VA + off); } else { pq[c2] = zero4; pk[c2] = zero4; pv[c2] = zero4; } }
    for (int ch = 0; ch < nchunk; ++ch) {
        const int row0 = rowbase + ch * 64;
        const bool valid = lane < L;
        const float ig = valid ? GA[(size_t)(row0 + lane) * 8 + h] : -1e30f, lf = valid ? GA[(size_t)(row0 + lane) * 8 + 4 + h] : 0.f;
        const float bcs = scan_add(lf, lane), blast = __shfl(bcs, 63);
        const float av = ig - bcs;
        const float Mv = fmaxf(m, scan_max(av, lane));
        const float iw = __expf(m - Mv), emt = __expf(-(bcs + Mv));
        const float gv = blast + av, mnew = fmaxf(blast + m, wave_max(gv));
        const float wprev = __expf(blast + m - mnew), wsv = __expf(gv - mnew);
        __syncthreads();
#pragma unroll
        for (int c2 = 0; c2 < 2; ++c2) { const int ci = tid + 512 * c2, r = ci >> 4, c16 = ci & 15; const int lo = r * MLP + 8 * c16;
            *(LAS v4u*)(Qs + lo) = pq[c2]; *(LAS v4u*)(Ks + lo) = pk[c2]; *(LAS v4u*)(Vs + lo) = pv[c2];
            const float sc = __shfl(wsv, r) * 0.08838834764831845f; v4u kw;
            kw.x = pk2(bflo(pk[c2].x) * sc, bfhi(pk[c2].x) * sc); kw.y = pk2(bflo(pk[c2].y) * sc, bfhi(pk[c2].y) * sc);
            kw.z = pk2(bflo(pk[c2].z) * sc, bfhi(pk[c2].z) * sc); kw.w = pk2(bflo(pk[c2].w) * sc, bfhi(pk[c2].w) * sc);
            *(LAS v4u*)(Kws + lo) = kw; }
        if (ch + 1 < nchunk) {
#pragma unroll
            for (int c2 = 0; c2 < 2; ++c2) { const int ci = tid + 512 * c2, r = ci >> 4, c16 = ci & 15; const size_t off = (size_t)(row0 + 64 + r) * 512 + h * 128 + 8 * c16;
                pq[c2] = *(const v4u*)(QA + off); pk[c2] = *(const v4u*)(KA + off); pv[c2] = *(const v4u*)(VA + off); } }
        __syncthreads();
        { const int st = w >> 1, lt0 = 2 * (w & 1);
          f32x4 sacc[2] = {{0.f, 0.f, 0.f, 0.f}, {0.f, 0.f, 0.f, 0.f}};
#pragma unroll
          for (int ks = 0; ks < 4; ++ks) { const bf16x8 a = *(const LAS bf16x8*)(Ks + (16 * st + li) * MLP + 32 * ks + 8 * q);
#pragma unroll
              for (int t2 = 0; t2 < 2; ++t2) { const bf16x8 bq = *(const LAS bf16x8*)(Qs + (16 * (lt0 + t2) + li) * MLP + 32 * ks + 8 * q); sacc[t2] = mfma16(a, bq, sacc[t2]); } }
          float a4[4];
#pragma unroll
          for (int r = 0; r < 4; ++r) a4[r] = __shfl(av, 16 * st + 4 * q + r);
#pragma unroll
          for (int t2 = 0; t2 < 2; ++t2) { const int l = 16 * (lt0 + t2) + li; const float Ml = __shfl(Mv, l); float vals[4], ps = 0.f;
#pragma unroll
              for (int r = 0; r < 4; ++r) { const int s = 16 * st + 4 * q + r; vals[r] = (s <= l) ? sacc[t2][r] * 0.08838834764831845f * __expf(a4[r] - Ml) : 0.f; ps += vals[r]; }
              ps += __shfl_xor(ps, 16); ps += __shfl_xor(ps, 32);
              if (q == 0) SpS[st * 64 + l] = ps;
              u32x2 o; o.x = pk2(vals[0], vals[1]); o.y = pk2(vals[2], vals[3]);
              *(LAS u32x2*)(Ss + l * MSP + 16 * st + 4 * q) = o; }
          { const int l = tid >> 3, part = tid & 7; const LAS unsigned* qp = (const LAS unsigned*)(Qs + l * MLP + 16 * part); const LAS float* np = nS + 16 * part; float s = 0.f;
#pragma unroll
            for (int e = 0; e < 8; ++e) { const unsigned wq = qp[e]; s += bflo(wq) * np[2 * e] + bfhi(wq) * np[2 * e + 1]; }
            s += __shfl_xor(s, 1); s += __shfl_xor(s, 2); s += __shfl_xor(s, 4);
            if (part == 0) qnS[l] = s; } }
        __syncthreads();
        bf16x8 vf[2];
        { f32x4 nacc[4];
#pragma unroll
          for (int lt = 0; lt < 4; ++lt) nacc[lt] = (f32x4){0.f, 0.f, 0.f, 0.f};
#pragma unroll
          for (int ks = 0; ks < 4; ++ks) { const bf16x8 a = *(const LAS bf16x8*)(CT + (16 * w + li) * MLP + 32 * ks + 8 * q);
#pragma unroll
              for (int lt = 0; lt < 4; ++lt) { const bf16x8 bq = *(const LAS bf16x8*)(Qs + (16 * lt + li) * MLP + 32 * ks + 8 * q); nacc[lt] = mfma16(a, bq, nacc[lt]); } }
#pragma unroll
          for (int lt = 0; lt < 4; ++lt) { const float iwl = __shfl(iw, 16 * lt + li); nacc[lt] = nacc[lt] * iwl; }
#pragma unroll
          for (int k2 = 0; k2 < 2; ++k2) { const LAS unsigned short* vp = Vs + (32 * k2 + 8 * q + qq) * MLP + 16 * w + 4 * pp;
              vf[k2] = cat8(ldtr(vp), ldtr(vp + 4 * MLP));
#pragma unroll
              for (int lt = 0; lt < 4; ++lt) { const bf16x8 bs = *(const LAS bf16x8*)(Ss + (16 * lt + li) * MSP + 32 * k2 + 8 * q); nacc[lt] = mfma16(vf[k2], bs, nacc[lt]); } }
          const float den = iw * qnS[lane] + ((SpS[lane] + SpS[64 + lane]) + (SpS[128 + lane] + SpS[192 + lane]));
          const float rs = 1.0f / fmaxf(fabsf(den), emt);
#pragma unroll
          for (int lt = 0; lt < 4; ++lt) { const int l = 16 * lt + li; const float rsl = __shfl(rs, l); nacc[lt] = nacc[lt] * rsl;
              float ss = (nacc[lt][0] * nacc[lt][0] + nacc[lt][1] * nacc[lt][1]) + (nacc[lt][2] * nacc[lt][2] + nacc[lt][3] * nacc[lt][3]);
              ss += __shfl_xor(ss, 16); ss += __shfl_xor(ss, 32);
              if (q == 0) ssS[w * 64 + l] = ss; }
          __syncthreads();
          float tot = 0.f;
#pragma unroll
          for (int w2 = 0; w2 < 8; ++w2) tot += ssS[w2 * 64 + lane];
          const float rstd = 1.0f / sqrtf(tot * (1.0f / 128.0f) + EPS);
          const f32x4 gn = *(const f32x4*)(gnorm + 16 * w + 4 * q);
#pragma unroll
          for (int lt = 0; lt < 4; ++lt) { const int l = 16 * lt + li; const float rl = __shfl(rstd, l);
              if (l < L) { const size_t row = (size_t)(row0 + l); const u32x2 ov = *(const u32x2*)(OA + row * 512 + h * 128 + 16 * w + 4 * q);
                  const float o0 = nacc[lt][0] * rl * gn[0] * fast_sigmoid(bflo(ov.x)), o1 = nacc[lt][1] * rl * gn[1] * fast_sigmoid(bfhi(ov.x));
                  const float o2 = nacc[lt][2] * rl * gn[2] * fast_sigmoid(bflo(ov.y)), o3 = nacc[lt][3] * rl * gn[3] * fast_sigmoid(bfhi(ov.y));
                  u32x2 o; o.x = pk2(o0, o1); o.y = pk2(o2, o3);
                  *(u32x2*)(MIX + row * 1024 + h * 128 + 16 * w + 4 * q) = o; } } }
#pragma unroll
        for (int i = 0; i < 8; ++i) accC[i] = accC[i] * wprev;
#pragma unroll
        for (int k2 = 0; k2 < 2; ++k2) {
#pragma unroll
            for (int i = 0; i < 8; ++i) { const LAS unsigned short* kp = Kws + (32 * k2 + 8 * q + qq) * MLP + 16 * i + 4 * pp;
                const bf16x8 a = cat8(ldtr(kp), ldtr(kp + 4 * MLP)); accC[i] = mfma16(a, vf[k2], accC[i]); } }
#pragma unroll
        for (int i = 0; i < 8; ++i) { u32x2 o; o.x = pk2(accC[i][0], accC[i][1]); o.y = pk2(accC[i][2], accC[i][3]); *(LAS u32x2*)(CT + (16 * w + li) * MLP + 16 * i + 4 * q) = o; }
        if (tid < 128) { float s = 0.f;
#pragma unroll 8
            for (int r = 0; r < 64; ++r) s += bf2f(Kws[r * MLP + tid]);
            nS[tid] = wprev * nS[tid] + s; }
        m = mnew;
    }
#pragma unroll
    for (int i = 0; i < 8; ++i)
#pragma unroll
        for (int r = 0; r < 4; ++r) Cout[(size_t)(16 * i + 4 * q + r) * 128 + 16 * w + li] = accC[i][r];
    if (tid < 128) nout[tid] = nS[tid];
    if (tid == 0) *mout = m;
}

constexpr int AT_P = 72;
template <int NKT>
__device__ __forceinline__ void attn_block(f32x4 (&accO)[4], float& mrun, float& lrun, const LAS unsigned short* Kt, const LAS unsigned short* Vt, const bf16x8 (&qf)[2],
                                           int rel0, const LAS float* tbl, bool far, int nvalid, int li, int q) {
    const int qq = li >> 2, pp = li & 3;
    f32x4 s[NKT];
#pragma unroll
    for (int kt = 0; kt < NKT; ++kt) { s[kt] = (f32x4){0.f, 0.f, 0.f, 0.f};
#pragma unroll
        for (int ks = 0; ks < 2; ++ks) { const bf16x8 a = *(const LAS bf16x8*)(Kt + (16 * kt + li) * AT_P + 32 * ks + 8 * q); s[kt] = mfma16(a, qf[ks], s[kt]); } }
    float mx = -1e30f;
    if (far) { const float b0 = tbl[0];
#pragma unroll
        for (int kt = 0; kt < NKT; ++kt)
#pragma unroll
            for (int r = 0; r < 4; ++r) { s[kt][r] = s[kt][r] * 0.125f + b0; mx = fmaxf(mx, s[kt][r]); }
    } else {
#pragma unroll
        for (int kt = 0; kt < NKT; ++kt)
#pragma unroll
            for (int r = 0; r < 4; ++r) { const int key = 16 * kt + 4 * q + r; int rel = rel0 + key; rel = rel < -128 ? -128 : (rel > 128 ? 128 : rel);
                float v = s[kt][r] * 0.125f + tbl[rel + 128]; v = key < nvalid ? v : -1e30f; s[kt][r] = v; mx = fmaxf(mx, v); }
    }
    mx = fmaxf(mx, __shfl_xor(mx, 16)); mx = fmaxf(mx, __shfl_xor(mx, 32));
    const float mnew = fmaxf(mrun, mx), alpha = __expf(mrun - mnew); mrun = mnew;
    float ps = 0.f;
#pragma unroll
    for (int kt = 0; kt < NKT; ++kt)
#pragma unroll
        for (int r = 0; r < 4; ++r) { const float p = __expf(s[kt][r] - mnew); s[kt][r] = p; ps += p; }
    lrun = lrun * alpha + ps;
#pragma unroll
    for (int dt = 0; dt < 4; ++dt) accO[dt] = accO[dt] * alpha;
#pragma unroll
    for (int k2 = 0; k2 < NKT / 2; ++k2) {
        v4u pw; pw.x = pk2(s[2 * k2][0], s[2 * k2][1]); pw.y = pk2(s[2 * k2][2], s[2 * k2][3]); pw.z = pk2(s[2 * k2 + 1][0], s[2 * k2 + 1][1]); pw.w = pk2(s[2 * k2 + 1][2], s[2 * k2 + 1][3]);
        const bf16x8 pb = __builtin_bit_cast(bf16x8, pw);
#pragma unroll
        for (int dt = 0; dt < 4; ++dt) { const LAS unsigned short* vp = Vt + (32 * k2 + 4 * q + qq) * AT_P + 16 * dt + 4 * pp;
            const bf16x8 a = cat8(ldtr(vp), ldtr(vp + 16 * AT_P)); accO[dt] = mfma16(a, pb, accO[dt]); } }
}
__device__ __forceinline__ void attn_store(const f32x4 (&accO)[4], float lrun, unsigned short* dst  , int q) {
    lrun += __shfl_xor(lrun, 16); lrun += __shfl_xor(lrun, 32);
    const float inv = 1.0f / lrun;
#pragma unroll
    for (int dt = 0; dt < 4; ++dt) { u32x2 o; o.x = pk2(accO[dt][0] * inv, accO[dt][1] * inv); o.y = pk2(accO[dt][2] * inv, accO[dt][3] * inv); *(u32x2*)(dst + 16 * dt + 4 * q) = o; }
}
constexpr int AT_TBL = 118784, AT_BUF = 0;
__device__ __forceinline__ void band_prompt_unit(LAS unsigned char* lds, const unsigned short* QB, const unsigned short* KB, const unsigned short* VB, unsigned short* MIX, int b, int c, int hp, int tid) {
    const int lane = tid & 63, w = __builtin_amdgcn_readfirstlane(tid >> 6), li = lane & 15, q = lane >> 4, hl = w >> 2, head = 2 * hp + hl, qoff = 16 * (w & 3) + li;
    const LAS float* tbl = (const LAS float*)(lds + AT_TBL) + head * 264;
    constexpr int BUFE = 2 * 64 * AT_P;
    LAS unsigned short* Kbuf = (LAS unsigned short*)(lds + AT_BUF); LAS unsigned short* Vbuf = Kbuf + 2 * BUFE;
    const size_t qrow = (size_t)b * 2048 + c * 64 + qoff;
    bf16x8 qf[2];
#pragma unroll
    for (int ks = 0; ks < 2; ++ks) qf[ks] = *(const bf16x8*)(QB + qrow * 512 + head * 64 + 32 * ks + 8 * q);
    f32x4 accO[4];
#pragma unroll
    for (int dt = 0; dt < 4; ++dt) accO[dt] = (f32x4){0.f, 0.f, 0.f, 0.f};
    float mrun = -1e30f, lrun = 0.f;
    const int kc0 = c > 8 ? c - 8 : 0;
    v4u rk[2], rv[2];
#define AT_GLOAD(kc_) do { _Pragma("unroll") for (int c2 = 0; c2 < 2; ++c2) { const int ci = tid + 512 * c2, key = ci >> 4, c16 = ci & 15; const size_t off = ((size_t)b * 2048 + (kc_) * 64 + key) * 512 + hp * 128 + 8 * c16; \
            rk[c2] = *(const v4u*)(KB + off); rv[c2] = *(const v4u*)(VB + off); } } while (0)
#define AT_LWRITE(buf_) do { _Pragma("unroll") for (int c2 = 0; c2 < 2; ++c2) { const int ci = tid + 512 * c2, key = ci >> 4, c16 = ci & 15; const int lo = (buf_) * BUFE + (c16 >> 3) * 64 * AT_P + key * AT_P + 8 * (c16 & 7); \
            *(LAS v4u*)(Kbuf + lo) = rk[c2]; *(LAS v4u*)(Vbuf + lo) = rv[c2]; } } while (0)
    __syncthreads();
    AT_GLOAD(kc0); AT_LWRITE(0);
    __syncthreads();
    int cur = 0;
    for (int kc = kc0; kc <= c; ++kc) {
        if (kc < c) AT_GLOAD(kc + 1);
        attn_block<4>(accO, mrun, lrun, Kbuf + cur * BUFE + hl * 64 * AT_P, Vbuf + cur * BUFE + hl * 64 * AT_P, qf, (kc - c) * 64 - qoff, tbl, kc + 3 <= c, 64, li, q);
        if (kc < c) AT_LWRITE(cur ^ 1);
        __syncthreads();
        cur ^= 1;
    }
    attn_store(accO, lrun, MIX + qrow * 1024 + 512 + head * 64, q);
}
__device__ __forceinline__ void band_sample_unit(LAS unsigned char* lds, const unsigned short* QB, const unsigned short* KB, const unsigned short* VB, const float* ck, const float* cv, unsigned short* MIX, int b, int tid) {
    const int lane = tid & 63, w = __builtin_amdgcn_readfirstlane(tid >> 6), li = lane & 15, q = lane >> 4;
    const LAS float* tbl = (const LAS float*)(lds + AT_TBL) + w * 264;
    constexpr int HE = 32 * AT_P;
    LAS unsigned short* Kbuf = (LAS unsigned short*)(lds + AT_BUF); LAS unsigned short* Vbuf = Kbuf + 8 * HE;
    const size_t qrow = (size_t)MP + b * 16 + li;
    bf16x8 qf[2];
#pragma unroll
    for (int ks = 0; ks < 2; ++ks) qf[ks] = *(const bf16x8*)(QB + qrow * 512 + w * 64 + 32 * ks + 8 * q);
    f32x4 accO[4];
#pragma unroll
    for (int dt = 0; dt < 4; ++dt) accO[dt] = (f32x4){0.f, 0.f, 0.f, 0.f};
    float mrun = -1e30f, lrun = 0.f;
    for (int kb = 0; kb <= 16; ++kb) {
        __syncthreads();
        if (kb < 16) {
#pragma unroll
            for (int i = 0; i < 8; ++i) { const int fi = tid + 512 * i, key = fi >> 7, c4 = fi & 127; const size_t off = ((size_t)b * 512 + 32 * kb + key) * 512 + 4 * c4;
                const f32x4 kx = *(const f32x4*)(ck + off), vx = *(const f32x4*)(cv + off); const int lo = (c4 >> 4) * HE + key * AT_P + 4 * (c4 & 15);
                u32x2 o; o.x = pk2(kx[0], kx[1]); o.y = pk2(kx[2], kx[3]); *(LAS u32x2*)(Kbuf + lo) = o;
                o.x = pk2(vx[0], vx[1]); o.y = pk2(vx[2], vx[3]); *(LAS u32x2*)(Vbuf + lo) = o; }
        } else {
#pragma unroll
            for (int c2 = 0; c2 < 4; ++c2) { const int ci = tid + 512 * c2, key = ci >> 6, c16 = ci & 63; const int lo = (c16 >> 3) * HE + key * AT_P + 8 * (c16 & 7);
                v4u kx = {0u, 0u, 0u, 0u}, vx = {0u, 0u, 0u, 0u};
                if (key < 16) { const size_t off = ((size_t)MP + b * 16 + key) * 512 + 8 * c16; kx = *(const v4u*)(KB + off); vx = *(const v4u*)(VB + off); }
                *(LAS v4u*)(Kbuf + lo) = kx; *(LAS v4u*)(Vbuf + lo) = vx; }
        }
        __syncthreads();
        if (kb < 16) attn_block<2>(accO, mrun, lrun, Kbuf + w * HE, Vbuf + w * HE, qf, 32 * kb - 512 - li, tbl, kb <= 11, 32, li, q);
        else attn_block<2>(accO, mrun, lrun, Kbuf + w * HE, Vbuf + w * HE, qf, -li, tbl, false, 16, li, q);
    }
    attn_store(accO, lrun, MIX + qrow * 1024 + 512 + w * 64, q);
}

__device__ __forceinline__ void mixer_phase(const Ctx& A, LAS unsigned char* lds, int vcu, int G, int tid) {
    unsigned char* ws = A.ws; float* out = A.out;
    const unsigned short* U = (const unsigned short*)(ws + WS_BIG);
    const unsigned short *QA = U, *KA = U + U_ELEMS, *VA = U + 2 * U_ELEMS, *OA = U + 3 * U_ELEMS, *QB = U + 4 * U_ELEMS, *KB = U + 5 * U_ELEMS, *VB = U + 6 * U_ELEMS;
    unsigned short* MIX = (unsigned short*)(ws + WS_XN); const float* GA = (const float*)(ws + WS_GA);
    const int NSEQ = 32;
    if (vcu < NSEQ) {
        const int b = vcu >> 2, h = vcu & 3;
        mlstm_seq(lds, QA, KA, VA, OA, GA, MIX, inptr(22) + h * 128, b * 2048, h, 32, 64, nullptr, nullptr, nullptr,
                  out + O_PAC + (size_t)(b * 4 + h) * 16384, out + O_PAN + (b * 4 + h) * 128, out + O_PAM + b * 4 + h, tid);
        return;
    }
    const int wk = vcu - NSEQ, NWK = G - NSEQ;
    { LAS float* tb = (LAS float*)(lds + AT_TBL); for (int i = tid; i < 8 * 257; i += 512) tb[(i / 257) * 264 + (i % 257)] = inptr(25)[i]; }
    constexpr int N_BS = 32, N_MS = 128, N_BP = 1024;
    for (int it = wk; it < N_BS + N_MS + N_BP; it += NWK) {
        if (it < N_BS) { band_sample_unit(lds, QB, KB, VB, inptr(5), inptr(6), MIX, it, tid); }
        else if (it < N_BS + N_MS) { const int u = it - N_BS, b = u >> 2, h = u & 3;
            __syncthreads();
            mlstm_seq(lds, QA, KA, VA, OA, GA, MIX, inptr(22) + h * 128, MP + b * 16, h, 1, 16,
                      inptr(2) + (size_t)(b * 4 + h) * 16384, inptr(3) + (b * 4 + h) * 128, inptr(4) + b * 4 + h,
                      out + O_SAC + (size_t)(b * 4 + h) * 16384, out + O_SAN + (b * 4 + h) * 128, out + O_SAM + b * 4 + h, tid); }
        else { const int u = it - N_BS - N_MS, hp = u & 3, c = (u >> 2) & 31, b = u >> 7; band_prompt_unit(lds, QB, KB, VB, MIX, b, c, hp, tid); }
    }
}

constexpr int RG_XB = 0, RG_GB = 18432, RG_XCB = 35840, RG_XCF = 53248, RG_Y = 87040, RG_HIN = 104448;
constexpr int RGP = 136, RGF = 132;
template <int PASS>
__device__ __forceinline__ void rglru_unit(const Ctx& A, LAS unsigned char* lds, bool sample, int b, int tt, int tid) {
    unsigned char* ws = A.ws; float* out = A.out;
    const unsigned short* GBg = (const unsigned short*)(ws + WS_BIG); const unsigned short* XBg = GBg + (size_t)MT * 1024;
    unsigned short* YC = (unsigned short*)(ws + WS_XN); const unsigned short* GW = (const unsigned short*)(ws + WS_WGATE);
    float* CA = (float*)(ws + WS_CARRY); float* CU = CA + 8 * 32 * 1024;
    const int lane = tid & 63, w = __builtin_amdgcn_readfirstlane(tid >> 6), li = lane & 15, q = lane >> 4;
    const int L = sample ? 16 : 64, MTL = sample ? 1 : 4, row0 = sample ? MP + 16 * b : b * 2048 + 64 * tt;
    LAS unsigned short* XBs = (LAS unsigned short*)(lds + RG_XB); LAS unsigned short* GBs = (LAS unsigned short*)(lds + RG_GB); LAS unsigned short* XCB = (LAS unsigned short*)(lds + RG_XCB);
    LAS float* XCF = (LAS float*)(lds + RG_XCF); LAS unsigned short* Ys = (LAS unsigned short*)(lds + RG_Y); LAS float* hin = (LAS float*)(lds + RG_HIN);
    __syncthreads();
    if (PASS == 2) {
#pragma unroll
        for (int e = 0; e < 2; ++e) { const int chn = tid + 512 * e; float hv;
            if (sample) hv = inptr(8)[(size_t)b * 1024 + chn];
            else { hv = 0.f; for (int k = 0; k < tt; ++k) hv = CA[((size_t)b * 32 + k) * 1024 + chn] * hv + CU[((size_t)b * 32 + k) * 1024 + chn]; }
            hin[chn] = hv; }
    }
    const float* convw = inptr(28); const float* convb = inptr(29); const float* gateb = inptr(31); const float* lam = inptr(32);
    for (int n = 0; n < 8; ++n) {
        const int ch0 = 128 * n;
        for (int ci = tid; ci < (L + 3) * 16; ci += 512) { const int r = ci >> 4, c16 = ci & 15, tr = r - 3; v4u v = {0u, 0u, 0u, 0u};
            if (tr >= 0 || (!sample && tt > 0)) v = *(const v4u*)(XBg + (size_t)(row0 + tr) * 1024 + ch0 + 8 * c16);
            else if (sample) { const float* cp = inptr(7) + ((size_t)b * 3 + r) * 1024 + ch0 + 8 * c16; const f32x4 c0 = *(const f32x4*)cp, c1 = *(const f32x4*)(cp + 4);
                v.x = pk2(c0[0], c0[1]); v.y = pk2(c0[2], c0[3]); v.z = pk2(c1[0], c1[1]); v.w = pk2(c1[2], c1[3]); }
            *(LAS v4u*)(XBs + r * RGP + 8 * c16) = v; }
        if (PASS == 2) for (int ci = tid; ci < L * 16; ci += 512) { const int r = ci >> 4, c16 = ci & 15; *(LAS v4u*)(GBs + r * RGP + 8 * c16) = *(const v4u*)(GBg + (size_t)(row0 + r) * 1024 + ch0 + 8 * c16); }
        __syncthreads();
        { const int chl = tid & 127, tg = tid >> 7;
          if (tg * 16 < L) { const float w0 = convw[ch0 + chl], w1 = convw[1024 + ch0 + chl], w2 = convw[2048 + ch0 + chl], w3 = convw[3072 + ch0 + chl], cb = convb[ch0 + chl];
              float x0 = bf2f(XBs[(tg * 16 + 0) * RGP + chl]), x1 = bf2f(XBs[(tg * 16 + 1) * RGP + chl]), x2 = bf2f(XBs[(tg * 16 + 2) * RGP + chl]);
#pragma unroll
              for (int i = 0; i < 16; ++i) { const float x3 = bf2f(XBs[(tg * 16 + i + 3) * RGP + chl]); const float xc = cb + w0 * x0 + w1 * x1 + w2 * x2 + w3 * x3;
                  XCF[(tg * 16 + i) * RGF + chl] = xc; XCB[(tg * 16 + i) * RGP + chl] = (unsigned short)(pk2(xc, 0.f) & 0xffffu); x0 = x1; x1 = x2; x2 = x3; } } }
        __syncthreads();
        bf16x8 br[4], bi[4];
#pragma unroll
        for (int ks = 0; ks < 4; ++ks) { br[ks] = *(const bf16x8*)(GW + ((size_t)n * 256 + 16 * w + li) * 128 + 32 * ks + 8 * q); bi[ks] = *(const bf16x8*)(GW + ((size_t)n * 256 + 128 + 16 * w + li) * 128 + 32 * ks + 8 * q); }
        const int chn = ch0 + 16 * w + li;
        const float gbr = gateb[chn], gbi = gateb[1024 + chn], lm = lam[chn];
        const float sp8 = 8.0f * (fmaxf(-lm, 0.f) + log1pf(expf(-fabsf(lm))));
        float aa[4][4], uu[4][4];
#pragma unroll
        for (int mt = 0; mt < 4; ++mt) {
            if (mt < MTL) { f32x4 ar = {0.f, 0.f, 0.f, 0.f}, ai = {0.f, 0.f, 0.f, 0.f};
#pragma unroll
                for (int ks = 0; ks < 4; ++ks) { const bf16x8 a = *(const LAS bf16x8*)(XCB + (16 * mt + li) * RGP + 32 * ks + 8 * q); ar = mfma16(a, br[ks], ar); ai = mfma16(a, bi[ks], ai); }
#pragma unroll
                for (int r = 0; r < 4; ++r) { const int t = 16 * mt + 4 * q + r; const float rr = fast_sigmoid(ar[r] + gbr), ii = fast_sigmoid(ai[r] + gbi);
                    const float la = -sp8 * rr; aa[mt][r] = __expf(la); uu[mt][r] = sqrtf(-expm1f(2.0f * la)) * ii * XCF[t * RGF + 16 * w + li]; }
            } else {
#pragma unroll
                for (int r = 0; r < 4; ++r) { aa[mt][r] = 1.f; uu[mt][r] = 0.f; } } }
        float hcar = (PASS == 2) ? hin[chn] : 0.f, atot = 1.f;
#pragma unroll
        for (int mt = 0; mt < 4; ++mt) { float sa = 1.f, su = 0.f;
#pragma unroll
            for (int r = 0; r < 4; ++r) { su = aa[mt][r] * su + uu[mt][r]; sa *= aa[mt][r]; }
            float myin = 0.f;
#pragma unroll
            for (int q2 = 0; q2 < 4; ++q2) { const float a2 = __shfl(sa, li + 16 * q2), u2 = __shfl(su, li + 16 * q2); myin = (q2 == q) ? hcar : myin; hcar = a2 * hcar + u2; atot *= a2; }
            if (PASS == 2 && mt < MTL) { float hh = myin;
#pragma unroll
                for (int r = 0; r < 4; ++r) { hh = aa[mt][r] * hh + uu[mt][r]; const int t = 16 * mt + 4 * q + r;
                    const float g = bf2f(GBs[t * RGP + 16 * w + li]); const float z = 0.7978845608028654f * (g + 0.044715f * g * g * g);
                    const float th = 1.0f - 2.0f * __builtin_amdgcn_rcpf(1.0f + __expf(2.0f * z)); const float y = 0.5f * g * (1.0f + th) * hh;
                    Ys[t * RGP + 16 * w + li] = (unsigned short)(pk2(y, 0.f) & 0xffffu); } } }
        if (PASS == 1) { if (q == 0) { CA[((size_t)b * 32 + tt) * 1024 + chn] = atot; CU[((size_t)b * 32 + tt) * 1024 + chn] = hcar; } }
        else { if (q == 0) { if (sample) out[O_SCH + (size_t)b * 1024 + chn] = hcar; else if (tt == 31) out[O_PCH + (size_t)b * 1024 + chn] = hcar; } }
        __syncthreads();
        if (PASS == 2) for (int ci = tid; ci < L * 16; ci += 512) { const int r = ci >> 4, c16 = ci & 15; *(v4u*)(YC + (size_t)(row0 + r) * 1024 + ch0 + 8 * c16) = *(const LAS v4u*)(Ys + r * RGP + 8 * c16); }
    }
}

#ifdef NO_GEMM
#define GEMM_CALL if (false)
#else
#define GEMM_CALL
#endif
__global__ void __launch_bounds__(NWAVES * 64, 2) fwd_megakernel(Args args) {
    extern __shared__ __attribute__((aligned(16))) unsigned char lds_raw[];
    LAS unsigned char* lds = (LAS unsigned char*)lds_raw;
    volatile LAS unsigned* MISC = (volatile LAS unsigned*)(lds + MISC_OFF);
    int tid = threadIdx.x, G = gridDim.x, bx = blockIdx.x;
    unsigned char* ws = args.ws; float* out = args.out;
#define lane (tid & 63)
#define wave (__builtin_amdgcn_readfirstlane(tid >> 6))
#define vcu ((G % 8 == 0) ? (bx % 8) * (G / 8) + bx / 8 : bx)
#define gw (vcu * NWAVES + wave)
#define NGW (G * NWAVES)
    gu32* ctl = (gu32*)(ws + WS_CTL);
    for (int u = tid; u < (LDS_BYTES - LDSCTL_OFF) / 4; u += NWAVES * 64) ((LAS unsigned*)(lds + LDSCTL_OFF))[u] = 0u;
    __syncthreads();
    XcdBarrier bar = xcd_barrier_post((unsigned*)(ctl + CW_BAR), MISC + 8);
#define GRID_BAR() do { xcd_barrier(bar); asm volatile("" : "+v"(tid)); asm volatile("" : "+s"(ws), "+s"(out)); asm volatile("" : "+s"(G), "+s"(bx)); } while (0)
#define ADAP ((float*)(ws + WS_ADAP))
#define ADA ((float*)(ws + WS_ADA))
#define XN ((unsigned short*)(ws + WS_XN))
#define BIG ((unsigned short*)(ws + WS_BIG))

#ifndef NO_P0
    { for (int it = vcu; it < 144; it += G) p0_ada_item(inptr(9), inptr(10), inptr(18), ADAP, (LAS float*)lds, it, tid);
      __syncthreads();
      p0_weights(Ctx{out, ws}, (LAS float*)(lds + wave * 16384), gw, NGW, lane); }
#endif
    GRID_BAR();
    { for (int i = (bx * 512 + tid); i < 2 * NBR * NADA / 4; i += G * 512) { const int e = i * 4, l = e / (NBR * NADA), n = e % NADA;
          f32x4 s = *(const f32x4*)(inptr(19) + (size_t)l * NADA + n);
#pragma unroll
          for (int ks = 0; ks < 8; ++ks) s = s + *(const f32x4*)(ADAP + (size_t)ks * 2 * NBR * NADA + e);
          *(f32x4*)(ADA + e) = s; } }
    GRID_BAR();

    for (int l = 0; l < 2; ++l) {
        const float* adaL = ADA + (size_t)l * NBR * NADA;
        for (int s = 0; s < 3; ++s) {
            const bool first = (l == 0 && s == 0);
            const float* xp = first ? inptr(0) : out; const float* xs = first ? inptr(1) : out + (size_t)MP * D;
            const float* nw = inptr(s == 0 ? 11 : (s == 1 ? 14 : 15)) + (size_t)l * D;
#ifndef NO_NORM
            if (l == 0 && s == 1) norm_phase<true>(xp, xs, nw, adaL, 3 * s, XN, inptr(20), inptr(21), (float*)(ws + WS_GA), (LAS float*)lds, gw, NGW, lane, tid);
            else norm_phase<false>(xp, xs, nw, adaL, 3 * s, XN, nullptr, nullptr, nullptr, (LAS float*)lds, gw, NGW, lane, tid);
#endif
            GRID_BAR();
            const unsigned short* rA; const unsigned short* rB; int rK; float rs;
            if (s != 1) {
                const int f = (s == 0 ? 0 : 2) + l;
                { pg8::Gemm g{XN, (const unsigned short*)(ws + WS_WFIN) + (size_t)f * FIN_ELEMS, MT, 2 * DFF, D}; pg8::StaticOrder S; S.init(MT, 2 * DFF, G, bx);
                  pg8::EpiSwiglu E{BIG, DFF};
                  GEMM_CALL pg8::gemm_phase<pg8::EpiSwiglu, pg8::StaticOrder, true, true>(lds, g, S, E, tid); }
                GRID_BAR();
                rA = BIG; rB = (const unsigned short*)(ws + WS_WFOUT) + (size_t)f * FOUT_ELEMS; rK = DFF; rs = 0.5f;
            } else if (l == 0) {
                { pg8::Gemm g{XN, (const unsigned short*)(ws + WS_WABIN), MT, 3584, D}; pg8::StaticOrder S; S.init(MT, 3584, G, bx);
                  pg8::EpiABin E{BIG, U_ELEMS, inptr(23), inptr(24), out + O_PBK, out + O_PBV, out + O_SBK, out + O_SBV, EPS};
                  GEMM_CALL pg8::gemm_phase<pg8::EpiABin, pg8::StaticOrder, true, true>(lds, g, S, E, tid); }
                GRID_BAR();
#ifndef NO_MIXER
                mixer_phase(Ctx{out, ws}, lds, vcu, G, tid);
#endif
                GRID_BAR();
                rA = XN; rB = (const unsigned short*)(ws + WS_WABOUT); rK = D; rs = 1.0f;
            } else {
                { pg8::Gemm g{XN, (const unsigned short*)(ws + WS_WCIN), MT, 2048, D}; pg8::StaticOrder S; S.init(MT, 2048, G, bx);
                  pg8::EpiCin E{BIG, BIG + (size_t)MT * 1024, out + O_PCC, out + O_SCC};
                  GEMM_CALL pg8::gemm_phase<pg8::EpiCin, pg8::StaticOrder, true, true>(lds, g, S, E, tid); }
                GRID_BAR();
#ifndef NO_RG
                for (int u = vcu; u < 256; u += G) rglru_unit<1>(Ctx{out, ws}, lds, false, u >> 5, u & 31, tid);
                GRID_BAR();
                for (int u = vcu; u < 256 + 32; u += G) { if (u < 256) rglru_unit<2>(Ctx{out, ws}, lds, false, u >> 5, u & 31, tid); else rglru_unit<2>(Ctx{out, ws}, lds, true, u - 256, 0, tid); }
#endif
                GRID_BAR();
                rA = XN; rB = (const unsigned short*)(ws + WS_WCOUT); rK = D; rs = 1.0f;
            }
            { pg8::Gemm g{rA, rB, MT, D, rK}; pg8::StaticOrder S; S.init(MT, D, G, bx);
              pg8::EpiRes E{xp, xs, out, adaL + (3 * s + 2) * 1024, rs};
              GEMM_CALL pg8::gemm_phase<pg8::EpiRes, pg8::StaticOrder, true, true>(lds, g, S, E, tid); }
            if (!(l == 1 && s == 2)) GRID_BAR();
        }
    }
}

extern "C" void kernel_launch(void* const* d_in, const int* in_sizes, int n_in, void* d_out, int out_size, void* d_ws, size_t ws_size, hipStream_t stream) {
    static int grid = 0;
    if (grid == 0) {
        if (n_in != 34 || (size_t)out_size != O_TOTAL || ws_size < WS_END) { fprintf(stderr, "kernel_launch: unexpected problem: n_in %d out %d ws %zu\n", n_in, out_size, ws_size); grid = -1; return; }
        int dev = 0, cus = 0, per_cu = 0;
        if (hipGetDevice(&dev) != hipSuccess || hipDeviceGetAttribute(&cus, hipDeviceAttributeMultiprocessorCount, dev) != hipSuccess) { grid = -1; return; }
        if (hipFuncSetAttribute((const void*)fwd_megakernel, hipFuncAttributeMaxDynamicSharedMemorySize, LDS_BYTES) != hipSuccess) { fprintf(stderr, "kernel_launch: hipFuncSetAttribute failed\n"); grid = -1; return; }
        if (hipOccupancyMaxActiveBlocksPerMultiprocessor(&per_cu, (const void*)fwd_megakernel, NWAVES * 64, LDS_BYTES) != hipSuccess || per_cu < 1) fprintf(stderr, "kernel_launch: occupancy query says %d\n", per_cu);
        (void)hipGetLastError();
        grid = cus;
    }
    if (grid < 0) return;
    (void)hipMemsetAsync((char*)d_ws + WS_CTL, 0, CTL_ZERO_BYTES, stream);
    Args a{};
    for (int i = 0; i < 34; ++i) a.in[i] = (const float*)d_in[i];
    a.out = (float*)d_out; a.ws = (unsigned char*)d_ws;
    hipLaunchKernelGGL(fwd_megakernel, dim3(grid), dim3(NWAVES * 64), LDS_BYTES, stream, a);
}
```

```cpp
#include <hip/hip_runtime.h>
#include <cstdio>
#include <cstdint>
namespace pg8 {
#define PG8_LAS __attribute__((address_space(3)))
typedef unsigned short bf16_t;
typedef short bf16x8 __attribute__((ext_vector_type(8)));
typedef float f32x4 __attribute__((ext_vector_type(4)));
typedef unsigned u32x4 __attribute__((ext_vector_type(4)));
constexpr int BM = 256, BK = 64, HALF = 128, HTB = HALF * BK * 2  , STAGE_BYTES = 8 * HTB, NXCD = 8, WGM = 2;

__host__ __device__ __forceinline__ int lds_byte(int r, int c) { const int st = (r >> 4) * 2 + (c >> 5), rr = r & 15, cc = c & 31, ob = rr * 64 + cc * 2; return st * 1024 + (ob ^ (((ob >> 9) & 1) << 5)); }
__host__ __device__ __forceinline__ void stage_rc(int b, int& R, int& C) { const int st = b / 1024, sb = b % 1024, swz = sb ^ (((sb >> 9) & 1) << 5); R = (st >> 1) * 16 + swz / 64; C = (st & 1) * 32 + (swz % 64) / 2; }
__host__ __device__ __forceinline__ int perm32(int rho) { const int n = rho >> 4, i = rho & 15; return 8 * (i >> 2) + 4 * n + (i & 3); }

struct Unit { int pm, pn, part; };
struct Gemm { const bf16_t* A; const bf16_t* Bt; int M, N, K; };

struct StaticOrder {
    int nM, nN, nwg, G, c, ntf;
    __host__ __device__ void init(int M, int N, int G_, int c_, int K_ = 0) { nM = M / BM; nN = N / BM; nwg = nM * nN; G = G_; c = c_; ntf = K_ / BK; }
    __host__ __device__ bool next(int i, Unit& u) const {
        const long L = (long)i * G + c; if (L >= nwg) return false;
        int wgid = (int)L; { const int q = nwg / NXCD, r = nwg % NXCD, xcd = wgid % NXCD, off = wgid / NXCD; wgid = (xcd < r ? xcd * (q + 1) : r * (q + 1) + (xcd - r) * q) + off; }
        const int nig = WGM * nN, gid = wgid / nig, fm = gid * WGM, gsz = (nM - fm) < WGM ? (nM - fm) : WGM;
        u.pm = fm + ((wgid % nig) % gsz); u.pn = (wgid % nig) / gsz; if (gid & 1) u.pn = nN - 1 - u.pn; u.part = -1; return true;
    }
    __host__ __device__ int k0(const Unit&) const { return 0; }
    __host__ __device__ int nt(const Unit&) const { return ntf; }
    __device__ __forceinline__ void a_ready(const Unit&, int) const {}
    __device__ __forceinline__ void done(const Unit&) const {}
};
struct GatedOrder : StaticOrder {
    const unsigned* ctr; unsigned need; mutable int seen;
    __device__ __forceinline__ void a_ready(const Unit& u, int wid) const {
        if (u.pm < 64 || seen) return;
        seen = 1;
        if (wid == 0) { unsigned sp = 0;
            while ((unsigned)__builtin_amdgcn_readfirstlane(__hip_atomic_load(ctr, __ATOMIC_RELAXED, __HIP_MEMORY_SCOPE_AGENT)) < need) { __builtin_amdgcn_s_sleep(2); if (++sp > (1u << 20)) break; }
            __builtin_amdgcn_fence(__ATOMIC_ACQUIRE, "agent");
            asm volatile("s_waitcnt vmcnt(0)" ::: "memory"); }
        asm volatile("" ::: "memory"); __builtin_amdgcn_s_barrier(); asm volatile("" ::: "memory");
    }
};
struct ResOrder {
    StaticOrder so; int nch, CH;
    __host__ __device__ void init(int G_, int c_, int K_, int CH_) { so.init(16384, 1024, G_, c_, K_); CH = CH_; nch = (K_ / BK) / CH_; }
    __host__ __device__ bool next(int i, Unit& u) const {
        if (so.next(i, u)) return true;
        const int imain = so.c < so.nwg ? (so.nwg - so.c + so.G - 1) / so.G : 0;
        const int j = (i - imain) * so.G + so.c; if (j >= 8 * nch) return false;
        u.pm = 64 + ((j & 7) >> 2); u.pn = j & 3; u.part = j >> 3; return true;
    }
    __host__ __device__ int k0(const Unit& u) const { return u.part < 0 ? 0 : u.part * CH; }
    __host__ __device__ int nt(const Unit& u) const { return u.part < 0 ? so.ntf : CH; }
    __device__ __forceinline__ void a_ready(const Unit&, int) const {}
    __device__ __forceinline__ void done(const Unit&) const {}
};
__device__ __forceinline__ unsigned cvt_pk_bf16(float lo, float hi) { unsigned r; asm volatile("v_cvt_pk_bf16_f32 %0, %1, %2" : "=v"(r) : "v"(lo), "v"(hi)); return r; }
typedef float f32x2 __attribute__((ext_vector_type(2)));
constexpr int MPROWS = 16384;
__device__ __forceinline__ int bidx(int row) { return row < MPROWS ? (row >> 11) : 8 + ((row - MPROWS) >> 4); }
typedef __bf16 bf16x2_t __attribute__((ext_vector_type(2)));
__device__ __forceinline__ unsigned pk2(float lo, float hi) { f32x2 v = {lo, hi}; bf16x2_t b = __builtin_convertvector(v, bf16x2_t); return __builtin_bit_cast(unsigned, b); }
__device__ __forceinline__ float fast_sigmoid(float x) { return __builtin_amdgcn_rcpf(1.0f + __builtin_amdgcn_exp2f(-1.44269504f * x)); }

template <int CTRL, int ROW_MASK = 0xf, int BANK_MASK = 0xf>
__device__ __forceinline__ float dppf(float old, float src) { return __int_as_float(__builtin_amdgcn_update_dpp(__float_as_int(old), __float_as_int(src), CTRL, ROW_MASK, BANK_MASK, false)); }
__device__ __forceinline__ float swz16(float v) { return __int_as_float(__builtin_amdgcn_ds_swizzle(__float_as_int(v), 0x401F)); }
__device__ __forceinline__ float bperm(float v, int srclane) { return __int_as_float(__builtin_amdgcn_ds_bpermute(srclane << 2, __float_as_int(v))); }
__device__ __forceinline__ float rdlane(float v, int l) { return __int_as_float(__builtin_amdgcn_readlane(__float_as_int(v), l)); }
__device__ __forceinline__ float qsum(float v) { v += swz16(v); const auto r = __builtin_amdgcn_permlane32_swap(__float_as_uint(v), __float_as_uint(v), false, false); return __uint_as_float(r[0]) + __uint_as_float(r[1]); }
__device__ __forceinline__ float qmax(float v) { v = fmaxf(v, swz16(v)); const auto r = __builtin_amdgcn_permlane32_swap(__float_as_uint(v), __float_as_uint(v), false, false); return fmaxf(__uint_as_float(r[0]), __uint_as_float(r[1])); }
__device__ __forceinline__ float rsum16(float v) { v += dppf<0xB1>(v, v); v += dppf<0x4E>(v, v); v += dppf<0x141>(v, v); v += dppf<0x140>(v, v); return v; }
__device__ __forceinline__ float rmax16(float v) { v = fmaxf(v, dppf<0xB1>(v, v)); v = fmaxf(v, dppf<0x4E>(v, v)); v = fmaxf(v, dppf<0x141>(v, v)); v = fmaxf(v, dppf<0x140>(v, v)); return v; }
__device__ __forceinline__ float rsum8(float v) { v += dppf<0xB1>(v, v); v += dppf<0x4E>(v, v); v += dppf<0x141>(v, v); return v; }
__device__ __forceinline__ float wave_sum(float v) { return qsum(rsum16(v)); }
__device__ __forceinline__ float wave_max(float v) { return qmax(rmax16(v)); }
__device__ __forceinline__ float scan_add(float v) {
    v += dppf<0x111>(0.f, v); v += dppf<0x112>(0.f, v); v += dppf<0x114>(0.f, v); v += dppf<0x118>(0.f, v);
    v += dppf<0x142, 0xa>(0.f, v); v += dppf<0x143, 0xc>(0.f, v); return v; }
__device__ __forceinline__ float scan_max(float v) { const float ni = -3.0e38f;
    v = fmaxf(v, dppf<0x111>(ni, v)); v = fmaxf(v, dppf<0x112>(ni, v)); v = fmaxf(v, dppf<0x114>(ni, v)); v = fmaxf(v, dppf<0x118>(ni, v));
    v = fmaxf(v, dppf<0x142, 0xa>(ni, v)); v = fmaxf(v, dppf<0x143, 0xc>(ni, v)); return v; }

template <bool FOLDED>
struct EpiSwigluT {
    static constexpr bool PERM = true, AFTER_DRAIN = false;
    static constexpr bool HAS_PRE = FOLDED; struct Pre { unsigned long long q; float b; };
    bf16_t* H; int ldh;
    const unsigned long long* ssq; const float* bias; PG8_LAS float* tab;
    __device__ __forceinline__ Pre pre_load(const Unit& u, int tid) const {
        Pre p{0ull, 0.f};
        if (ssq) { const int pm = u.pm < 64 ? u.pm : 63, i = tid & 255; p.q = ssq[pm * BM + i]; p.b = bias[(size_t)(pm >> 3) * 5632 + u.pn * BM + i]; }
        return p; }
    __device__ __forceinline__ void pre_store(const Pre& p, int tid) const {
        if (ssq) { if (tid < 256) tab[tid] = __builtin_amdgcn_rsqf((float)p.q * (1.0f / (268435456.0f * 1024.0f)) + 1e-6f); else tab[tid] = p.b; } }
    __device__ __forceinline__ void operator()(const f32x4 (&acc)[2][2][4][2], const Unit& u, int wr, int wc, int fr, int fq) const {
        const int row0 = u.pm * BM + wr * 64 + fr, col0 = u.pn * HALF + wc * 32 + 8 * fq;
        float rs[2][4]; f32x4 bg[2], bu[2];
#pragma unroll
        for (int ai = 0; ai < 2; ++ai)
#pragma unroll
            for (int m = 0; m < 4; ++m) rs[ai][m] = 1.0f;
        bg[0] = bg[1] = bu[0] = bu[1] = (f32x4){0.f, 0.f, 0.f, 0.f};
        if (FOLDED && u.pm < 64) {
#pragma unroll
            for (int ai = 0; ai < 2; ++ai)
#pragma unroll
                for (int m = 0; m < 4; ++m) rs[ai][m] = tab[ai * HALF + wr * 64 + m * 16 + fr];
            const PG8_LAS float* bp = tab + 256 + wc * 32 + 8 * fq;
            bg[0] = *(const PG8_LAS f32x4*)bp; bg[1] = *(const PG8_LAS f32x4*)(bp + 4); bu[0] = *(const PG8_LAS f32x4*)(bp + HALF); bu[1] = *(const PG8_LAS f32x4*)(bp + HALF + 4); }
#pragma unroll
        for (int ai = 0; ai < 2; ++ai)
#pragma unroll
            for (int m = 0; m < 4; ++m) { bf16_t* rowp = H + (size_t)(row0 + ai * HALF + m * 16) * ldh + col0;
                float h[8];
#pragma unroll
                for (int n = 0; n < 2; ++n)
#pragma unroll
                    for (int j = 0; j < 4; ++j) { const float g = FOLDED ? acc[ai][0][m][n][j] * rs[ai][m] + bg[n][j] : acc[ai][0][m][n][j], up = FOLDED ? acc[ai][1][m][n][j] * rs[ai][m] + bu[n][j] : acc[ai][1][m][n][j]; h[4 * n + j] = (g * up) * __builtin_amdgcn_rcpf(1.0f + __builtin_amdgcn_exp2f(g)); }
                u32x4 w; w.x = pk2(h[0], h[1]); w.y = pk2(h[2], h[3]); w.z = pk2(h[4], h[5]); w.w = pk2(h[6], h[7]);
                *(u32x4*)rowp = w; }
    }
};

typedef EpiSwigluT<false> EpiSwiglu;

struct EpiRes {
    static constexpr bool PERM = true, AFTER_DRAIN = false;
    static constexpr bool HAS_PRE = false; struct Pre {};
    const float* base_p; const float* base_s; bf16_t* xh; float* outf; const float* gate; float s; float* slab; int first, last; bf16_t* dummy;
    bf16_t* xs; const float* nwn; const float* scn; unsigned long long* ssq; int dropx;
    const bf16_t* xsb; const float* nwb; const float* scb;
    __device__ __forceinline__ void operator()(const f32x4 (&acc)[2][2][4][2], const Unit& u, int wr, int wc, int fr, int fq) const {
        const int row0 = u.pm * BM + wr * 64 + fr, col0 = u.pn * BM + wc * 32 + 8 * fq;
        if (u.part >= 0) {
#pragma unroll
            for (int ai = 0; ai < 2; ++ai)
#pragma unroll
                for (int m = 0; m < 4; ++m) { float* sp = slab + ((size_t)u.part * 512 + (size_t)(row0 + ai * HALF + m * 16 - MPROWS)) * 1024 + col0;
#pragma unroll
                    for (int bj = 0; bj < 2; ++bj)
#pragma unroll
                        for (int n = 0; n < 2; ++n) *(f32x4*)(sp + bj * HALF + 4 * n) = acc[ai][bj][m][n]; }
            return; }
        f32x4 gs0[2], gs1[2];
        { const float* gp = gate + (size_t)bidx(u.pm * BM) * 9216 + col0;
#pragma unroll
          for (int bj = 0; bj < 2; ++bj) { gs0[bj] = *(const f32x4*)(gp + bj * HALF) * s; gs1[bj] = *(const f32x4*)(gp + bj * HALF + 4) * s; } }
        const bool fold = xs != nullptr && !dummy;
        float ssrow[8];
#pragma unroll
        for (int e = 0; e < 8; ++e) ssrow[e] = 0.f;
        f32x4 ig0[2], ig1[2];
        ig0[0] = ig0[1] = ig1[0] = ig1[1] = (f32x4){1.f, 1.f, 1.f, 1.f};
        if (xsb) { const float* sp = scb + (size_t)bidx(u.pm * BM) * 9216 + col0; const float* np = nwb + col0;
#pragma unroll
            for (int bj = 0; bj < 2; ++bj) { const f32x4 d0 = *(const f32x4*)(np + bj * HALF) * (*(const f32x4*)(sp + bj * HALF) + 1.0f), d1 = *(const f32x4*)(np + bj * HALF + 4) * (*(const f32x4*)(sp + bj * HALF + 4) + 1.0f);
#pragma unroll
                for (int e = 0; e < 4; ++e) { ig0[bj][e] = __builtin_amdgcn_rcpf(d0[e]); ig1[bj][e] = __builtin_amdgcn_rcpf(d1[e]); } } }
        f32x4 gn0[2], gn1[2];
        gn0[0] = gn0[1] = gn1[0] = gn1[1] = (f32x4){0.f, 0.f, 0.f, 0.f};
        if (fold) { const float* sp = scn + (size_t)bidx(u.pm * BM) * 9216 + col0; const float* np = nwn + col0;
#pragma unroll
            for (int bj = 0; bj < 2; ++bj) { gn0[bj] = *(const f32x4*)(np + bj * HALF) * (*(const f32x4*)(sp + bj * HALF) + 1.0f); gn1[bj] = *(const f32x4*)(np + bj * HALF + 4) * (*(const f32x4*)(sp + bj * HALF + 4) + 1.0f); } }
#pragma unroll
        for (int ai = 0; ai < 2; ++ai)
#pragma unroll
            for (int m = 0; m < 4; ++m) { const int row = row0 + ai * HALF + m * 16; const size_t xo = (size_t)row * 1024 + col0; float ssr = 0.f;
#pragma unroll
                for (int bj = 0; bj < 2; ++bj) { f32x4 b0, b1;
                    if (first) { const float* bp = (row < MPROWS ? base_p + (size_t)row * 1024 : base_s + (size_t)(row - MPROWS) * 1024) + col0 + bj * HALF; b0 = *(const f32x4*)bp; b1 = *(const f32x4*)(bp + 4); }
                    else { const u32x4 w = *(const u32x4*)((xsb ? xsb : xh) + xo + bj * HALF);
                        b0 = (f32x4){__uint_as_float(w.x << 16), __uint_as_float(w.x & 0xffff0000u), __uint_as_float(w.y << 16), __uint_as_float(w.y & 0xffff0000u)} * ig0[bj];
                        b1 = (f32x4){__uint_as_float(w.z << 16), __uint_as_float(w.z & 0xffff0000u), __uint_as_float(w.w << 16), __uint_as_float(w.w & 0xffff0000u)} * ig1[bj]; }
                    const f32x4 o0 = b0 + gs0[bj] * acc[ai][bj][m][0], o1 = b1 + gs1[bj] * acc[ai][bj][m][1];
                    if (last && !dummy) { *(f32x4*)(outf + xo + bj * HALF) = o0; *(f32x4*)(outf + xo + bj * HALF + 4) = o1; }
                    else if (!(fold && dropx)) { bf16_t* xw = dummy ? dummy : xh; u32x4 w; w.x = pk2(o0[0], o0[1]); w.y = pk2(o0[2], o0[3]); w.z = pk2(o1[0], o1[1]); w.w = pk2(o1[2], o1[3]); *(u32x4*)(xw + xo + bj * HALF) = w; }
                    if (fold) { const f32x4 y0 = o0 * gn0[bj], y1 = o1 * gn1[bj];
                        u32x4 w; w.x = pk2(y0[0], y0[1]); w.y = pk2(y0[2], y0[3]); w.z = pk2(y1[0], y1[1]); w.w = pk2(y1[2], y1[3]); *(u32x4*)(xs + xo + bj * HALF) = w;
                        ssr += ((o0[0] * o0[0] + o0[1] * o0[1]) + (o0[2] * o0[2] + o0[3] * o0[3])) + ((o1[0] * o1[0] + o1[1] * o1[1]) + (o1[2] * o1[2] + o1[3] * o1[3])); } }
                if (fold) ssrow[ai * 4 + m] = qsum(ssr);
                asm volatile("" ::: "memory"); }
        if (fold) {
#pragma unroll
            for (int g = 0; g < 2; ++g) { const int rg = 2 * fq + g;
                float v = ssrow[0];
#pragma unroll
                for (int e = 1; e < 8; ++e) v = (rg == e) ? ssrow[e] : v;
                (void)__hip_atomic_fetch_add(ssq + row0 + (rg >> 2) * HALF + (rg & 3) * 16, (unsigned long long)(v * 268435456.0f), __ATOMIC_RELAXED, __HIP_MEMORY_SCOPE_AGENT); } }
    }
};

struct EpiABin {
    static constexpr bool PERM = true, AFTER_DRAIN = false;
    static constexpr bool HAS_PRE = false; struct Pre {};
    bf16_t* U; size_t tstride; const float* qnw; const float* knw; float* pbk; float* pbv; float* sbk; float* sbv; float eps; int plain;
    __device__ __forceinline__ void operator()(const f32x4 (&acc)[2][2][4][2], const Unit& u, int wr, int wc, int fr, int fq) const {
        const int t = u.pn >> 1, half = u.pn & 1;
        bf16_t* dst = U + (size_t)t * tstride;
        const int row0 = u.pm * BM + wr * 64 + fr, lc0 = 256 * half + 64 * wc + 8 * fq;
        const bool norm = (t == 4 || t == 5) && !plain;
        f32x4 nw[2][2];
        if (norm) { const float* w = (t == 4) ? qnw : knw;
#pragma unroll
            for (int bj = 0; bj < 2; ++bj)
#pragma unroll
                for (int n = 0; n < 2; ++n) nw[bj][n] = *(const f32x4*)(w + 32 * bj + 8 * fq + 4 * n); }
        const bool is_s = u.pm >= 64, is_ptail = (!is_s) && ((u.pm & 7) >= 6);
        float* fo = nullptr;
        if (t == 5 && !plain) fo = is_s ? sbk : (is_ptail ? pbk : nullptr);
        if (t == 6 && !plain) fo = is_s ? sbv : (is_ptail ? pbv : nullptr);
#pragma unroll
        for (int ai = 0; ai < 2; ++ai)
#pragma unroll
            for (int m = 0; m < 4; ++m) { const int row = row0 + ai * HALF + m * 16;
                f32x4 v[2][2];
#pragma unroll
                for (int bj = 0; bj < 2; ++bj)
#pragma unroll
                    for (int n = 0; n < 2; ++n) v[bj][n] = acc[ai][bj][m][n];
                if (norm) { float ss = 0.f;
#pragma unroll
                    for (int bj = 0; bj < 2; ++bj)
#pragma unroll
                        for (int n = 0; n < 2; ++n) ss += (v[bj][n][0] * v[bj][n][0] + v[bj][n][1] * v[bj][n][1]) + (v[bj][n][2] * v[bj][n][2] + v[bj][n][3] * v[bj][n][3]);
                    ss = qsum(ss);
                    const float rstd = 1.0f / sqrtf(ss * (1.0f / 64.0f) + eps);
#pragma unroll
                    for (int bj = 0; bj < 2; ++bj)
#pragma unroll
                        for (int n = 0; n < 2; ++n) v[bj][n] = v[bj][n] * rstd * nw[bj][n]; }
                bf16_t* rowp = dst + (size_t)row * 512 + lc0;
#pragma unroll
                for (int bj = 0; bj < 2; ++bj) { u32x4 w; w.x = pk2(v[bj][0][0], v[bj][0][1]); w.y = pk2(v[bj][0][2], v[bj][0][3]); w.z = pk2(v[bj][1][0], v[bj][1][1]); w.w = pk2(v[bj][1][2], v[bj][1][3]);
                    *(u32x4*)(rowp + 32 * bj) = w; }
                if (fo) { size_t orow;
                    if (is_s) orow = (size_t)(row - MPROWS); else orow = (size_t)(row >> 11) * 512 + (size_t)((row & 2047) - 1536);
                    float* op = fo + orow * 512 + lc0;
#pragma unroll
                    for (int bj = 0; bj < 2; ++bj)
#pragma unroll
                        for (int n = 0; n < 2; ++n) *(f32x4*)(op + 32 * bj + 4 * n) = v[bj][n]; }
            }
    }
};

template <bool FOLDED>
struct EpiCinT {
    static constexpr bool PERM = true, AFTER_DRAIN = false;
    static constexpr bool HAS_PRE = FOLDED; struct Pre { unsigned long long q; float b; };
    bf16_t* GB; bf16_t* XB; float* pcc; float* scc;
    const unsigned long long* ssq; const float* bias; PG8_LAS float* tab;
    __device__ __forceinline__ Pre pre_load(const Unit& u, int tid) const {
        Pre p{0ull, 0.f};
        if (FOLDED) { const int pm = u.pm < 64 ? u.pm : 63, i = tid & 255; p.q = ssq[pm * BM + i]; p.b = bias[(size_t)(pm >> 3) * 2048 + u.pn * BM + i]; }
        return p; }
    __device__ __forceinline__ void pre_store(const Pre& p, int tid) const {
        if (FOLDED) { if (tid < 256) tab[tid] = __builtin_amdgcn_rsqf((float)p.q * (1.0f / (268435456.0f * 1024.0f)) + 1e-6f); else tab[tid] = p.b; } }
    __device__ __forceinline__ void operator()(const f32x4 (&acc)[2][2][4][2], const Unit& u, int wr, int wc, int fr, int fq) const {
        const bool isx = u.pn >= 4; bf16_t* dst = isx ? XB : GB;
        const int row0 = u.pm * BM + wr * 64 + fr, col0 = 256 * (u.pn & 3) + wc * 32 + 8 * fq;
        const bool is_s = u.pm >= 64;
        float rs[2][4]; f32x4 bb[2][2];
#pragma unroll
        for (int ai = 0; ai < 2; ++ai)
#pragma unroll
            for (int m = 0; m < 4; ++m) rs[ai][m] = 1.0f;
        bb[0][0] = bb[0][1] = bb[1][0] = bb[1][1] = (f32x4){0.f, 0.f, 0.f, 0.f};
        if (FOLDED && !is_s) {
#pragma unroll
            for (int ai = 0; ai < 2; ++ai)
#pragma unroll
                for (int m = 0; m < 4; ++m) rs[ai][m] = tab[ai * HALF + wr * 64 + m * 16 + fr];
            const PG8_LAS float* bp = tab + 256 + wc * 32 + 8 * fq;
            bb[0][0] = *(const PG8_LAS f32x4*)bp; bb[0][1] = *(const PG8_LAS f32x4*)(bp + 4); bb[1][0] = *(const PG8_LAS f32x4*)(bp + HALF); bb[1][1] = *(const PG8_LAS f32x4*)(bp + HALF + 4); }
#pragma unroll
        for (int ai = 0; ai < 2; ++ai)
#pragma unroll
            for (int m = 0; m < 4; ++m) { const int row = row0 + ai * HALF + m * 16; bf16_t* rowp = dst + (size_t)row * 1024 + col0;
                f32x4 vv[2][2];
#pragma unroll
                for (int bj = 0; bj < 2; ++bj)
#pragma unroll
                    for (int n = 0; n < 2; ++n) vv[bj][n] = FOLDED ? acc[ai][bj][m][n] * rs[ai][m] + bb[bj][n] : acc[ai][bj][m][n];
#pragma unroll
                for (int bj = 0; bj < 2; ++bj) { const f32x4 v0 = vv[bj][0], v1 = vv[bj][1];
                    u32x4 w; w.x = pk2(v0[0], v0[1]); w.y = pk2(v0[2], v0[3]); w.z = pk2(v1[0], v1[1]); w.w = pk2(v1[2], v1[3]);
                    *(u32x4*)(rowp + bj * HALF) = w; }
                if (isx) { float* op = nullptr;
                    if (is_s) { const int r = row - MPROWS, tt = r & 15; if (tt >= 13) op = scc + ((size_t)(r >> 4) * 3 + (tt - 13)) * 1024 + col0; }
                    else { const int tt = row & 2047; if (tt >= 2045) op = pcc + ((size_t)(row >> 11) * 3 + (tt - 2045)) * 1024 + col0; }
                    if (op) {
#pragma unroll
                        for (int bj = 0; bj < 2; ++bj)
#pragma unroll
                            for (int n = 0; n < 2; ++n) *(f32x4*)(op + bj * HALF + 4 * n) = vv[bj][n]; } }
            }
    }
};
typedef EpiCinT<false> EpiCin;
template <class Epi, class Sched, bool ALIGN_EPI = false, bool SP2 = false>
__device__ __forceinline__ void gemm_phase(PG8_LAS unsigned char* lds, const Gemm g, const Sched& S, const Epi& E, const int tid) {
    const int wid = __builtin_amdgcn_readfirstlane(tid >> 6), lane = tid & 63, wr = wid >> 2, wc = wid & 3, fr = lane & 15, fq = lane >> 4;
    const int K = g.K;
    unsigned voffA[2], voffB[2];
#pragma unroll
    for (int i = 0; i < 2; ++i) { int R, C; stage_rc(tid * 16 + i * 8192, R, C); const int Rb = Epi::PERM ? ((R & ~31) + perm32(R & 31)) : R;
        voffA[i] = (unsigned)(R * K + C) * 2u; voffB[i] = (unsigned)(Rb * K + C) * 2u; }
    const size_t kstep = (size_t)(BK * 2);
    const size_t hstep = (size_t)HALF * K * 2;
    const size_t tstep = 2 * hstep;
    const unsigned ldsw = (unsigned)wid * 1024u;
    const int aoff = lds_byte(wr * 64 + fr, fq * 8), boff = lds_byte(wc * 32 + fr, fq * 8);
#define PG8_SA(b, h) (((b) * 2 + (h)) * HTB)
#define PG8_SB(b, h) ((4 + (b) * 2 + (h)) * HTB)
#define PG8_STAGE(bufoff, gbase, voff) do { _Pragma("unroll") for (int _i = 0; _i < 2; ++_i) \
        __builtin_amdgcn_global_load_lds((const unsigned*)((const char*)(gbase) + (voff)[_i]), (PG8_LAS unsigned*)(lds + (bufoff) + ldsw + _i * 8192), 16, 0, 0); } while (0)
#define PG8_LDA(dst, b, h) do { _Pragma("unroll") for (int m = 0; m < 4; ++m) _Pragma("unroll") for (int k = 0; k < 2; ++k) dst[m][k] = *(const PG8_LAS bf16x8*)(lds + PG8_SA(b, h) + aoff + m * 2048 + k * 1024); } while (0)
#define PG8_LDB(dst, b, h) do { _Pragma("unroll") for (int n = 0; n < 2; ++n) _Pragma("unroll") for (int k = 0; k < 2; ++k) dst[n][k] = *(const PG8_LAS bf16x8*)(lds + PG8_SB(b, h) + boff + n * 2048 + k * 1024); } while (0)
#define PG8_MMA(ai, bj, At, Bt) do { __builtin_amdgcn_s_setprio(1); _Pragma("unroll") for (int m = 0; m < 4; ++m) _Pragma("unroll") for (int n = 0; n < 2; ++n) _Pragma("unroll") for (int k = 0; k < 2; ++k) \
        acc[ai][bj][m][n] = __builtin_amdgcn_mfma_f32_16x16x32_bf16(Bt[n][k], At[m][k], acc[ai][bj][m][n], 0, 0, 0); __builtin_amdgcn_s_setprio(0); } while (0)
#define PG8_WAIT_V(n) asm volatile("s_waitcnt vmcnt(" #n ")" ::: "memory")
#define PG8_WAIT_L(n) asm volatile("s_waitcnt lgkmcnt(" #n ")" ::: "memory")
#define PG8_BAR __builtin_amdgcn_s_barrier()
#define PG8_SCHED __builtin_amdgcn_sched_barrier(0)
    Unit cur, nxt; int ui = 0;
    if (!S.next(0, cur)) return;
    f32x4 acc[2][2][4][2];
#pragma unroll
    for (int a = 0; a < 2; ++a)
#pragma unroll
        for (int b = 0; b < 2; ++b)
#pragma unroll
            for (int m = 0; m < 4; ++m)
#pragma unroll
                for (int n = 0; n < 2; ++n) acc[a][b][m][n] = (f32x4){0.f, 0.f, 0.f, 0.f};
    bf16x8 At[4][2], B0[2][2], B1[2][2];
    const char* cA = (const char*)g.A + (size_t)cur.pm * tstep + (size_t)S.k0(cur) * kstep; const char* cB = (const char*)g.Bt + (size_t)cur.pn * tstep + (size_t)S.k0(cur) * kstep;
    S.a_ready(cur, wid);
    if constexpr (SP2) {
        PG8_STAGE(PG8_SB(0, 0), cB, voffB); PG8_STAGE(PG8_SB(0, 1), cB + hstep, voffB); PG8_STAGE(PG8_SA(0, 0), cA, voffA); PG8_STAGE(PG8_SA(0, 1), cA + hstep, voffA);
        if (wr == 1) PG8_BAR;
        PG8_WAIT_V(2); PG8_BAR;
        PG8_STAGE(PG8_SB(1, 0), cB + kstep, voffB); PG8_STAGE(PG8_SA(1, 0), cA + kstep, voffA); PG8_STAGE(PG8_SB(1, 1), cB + hstep + kstep, voffB);
        PG8_WAIT_V(6); PG8_BAR;
    } else {
        PG8_STAGE(PG8_SB(0, 0), cB, voffB); PG8_STAGE(PG8_SA(0, 0), cA, voffA); PG8_STAGE(PG8_SB(0, 1), cB + hstep, voffB); PG8_STAGE(PG8_SA(0, 1), cA + hstep, voffA);
        if (wr == 1) PG8_BAR;
        PG8_WAIT_V(4); PG8_BAR;
        PG8_STAGE(PG8_SB(1, 0), cB + kstep, voffB); PG8_STAGE(PG8_SA(1, 0), cA + kstep, voffA); PG8_STAGE(PG8_SB(1, 1), cB + hstep + kstep, voffB);
        PG8_WAIT_V(6); PG8_BAR;
    }
    for (;;) {
        const bool has_next = S.next(ui + 1, nxt);
        const char* nA = has_next ? (const char*)g.A + (size_t)nxt.pm * tstep + (size_t)S.k0(nxt) * kstep : cA; const char* nB = has_next ? (const char*)g.Bt + (size_t)nxt.pn * tstep + (size_t)S.k0(nxt) * kstep : cB;
        const int nt = S.nt(cur);
        for (int t = 0; t < nt; t += 2) {
            const bool last = (t == nt - 2);
            const char* a1 = cA + (size_t)(t + 1) * kstep;
            const char* a2 = last ? nA : cA + (size_t)(t + 2) * kstep; const char* b2 = last ? nB : cB + (size_t)(t + 2) * kstep;
            const char* a3 = a2 + kstep; const char* b3 = b2 + kstep;
            if (last && has_next) S.a_ready(nxt, wid);
            typename Epi::Pre pre{};
            if constexpr (Epi::HAS_PRE) { if (last) pre = E.pre_load(cur, tid); }
            if constexpr (SP2) {
            PG8_LDB(B0, 0, 0); PG8_LDB(B1, 0, 1); PG8_SCHED; PG8_LDA(At, 0, 0); PG8_STAGE(PG8_SA(1, 1), a1 + hstep, voffA);
            PG8_WAIT_V(8); PG8_WAIT_L(0); PG8_BAR; PG8_MMA(0, 0, At, B0); PG8_MMA(0, 1, At, B1); PG8_BAR; PG8_SCHED;
            PG8_LDA(At, 0, 1); PG8_STAGE(PG8_SB(0, 0), b2, voffB); PG8_STAGE(PG8_SB(0, 1), b2 + hstep, voffB); PG8_STAGE(PG8_SA(0, 0), a2, voffA);
            PG8_WAIT_V(8); PG8_WAIT_L(0); PG8_BAR; PG8_MMA(1, 0, At, B0); PG8_MMA(1, 1, At, B1); PG8_BAR; PG8_SCHED;
            PG8_LDB(B0, 1, 0); PG8_LDB(B1, 1, 1); PG8_SCHED; PG8_LDA(At, 1, 0); PG8_STAGE(PG8_SA(0, 1), a2 + hstep, voffA);
            PG8_WAIT_V(8); PG8_WAIT_L(0); PG8_BAR; PG8_MMA(0, 0, At, B0); PG8_MMA(0, 1, At, B1); PG8_BAR; PG8_SCHED;
            PG8_LDA(At, 1, 1); PG8_STAGE(PG8_SB(1, 0), b3, voffB); PG8_STAGE(PG8_SB(1, 1), b3 + hstep, voffB); PG8_STAGE(PG8_SA(1, 0), a3, voffA);
            PG8_WAIT_V(8); PG8_WAIT_L(0); PG8_BAR; PG8_MMA(1, 0, At, B0); PG8_MMA(1, 1, At, B1);
            if constexpr (Epi::HAS_PRE) { if (last) { E.pre_store(pre, tid); PG8_WAIT_L(0); } }
            PG8_BAR; PG8_SCHED;
            } else {
            PG8_LDB(B0, 0, 0); PG8_SCHED; PG8_LDA(At, 0, 0); PG8_STAGE(PG8_SA(1, 1), a1 + hstep, voffA);
            PG8_WAIT_L(8); PG8_BAR; PG8_WAIT_L(0); PG8_MMA(0, 0, At, B0); PG8_BAR; PG8_SCHED;
            PG8_LDB(B1, 0, 1); PG8_STAGE(PG8_SB(0, 0), b2, voffB);
            PG8_BAR; PG8_WAIT_L(0); PG8_MMA(0, 1, At, B1); PG8_BAR;
            PG8_LDA(At, 0, 1); PG8_STAGE(PG8_SA(0, 0), a2, voffA);
            PG8_BAR; PG8_WAIT_L(0); PG8_MMA(1, 0, At, B0); PG8_BAR; PG8_SCHED;
            PG8_STAGE(PG8_SB(0, 1), b2 + hstep, voffB);
            PG8_WAIT_V(6); PG8_BAR; PG8_MMA(1, 1, At, B1); PG8_BAR;
            PG8_LDB(B0, 1, 0); PG8_SCHED; PG8_LDA(At, 1, 0); PG8_STAGE(PG8_SA(0, 1), a2 + hstep, voffA);
            PG8_WAIT_L(8); PG8_BAR; PG8_WAIT_L(0); PG8_MMA(0, 0, At, B0); PG8_BAR; PG8_SCHED;
            PG8_LDB(B1, 1, 1); PG8_STAGE(PG8_SB(1, 0), b3, voffB);
            PG8_BAR; PG8_WAIT_L(0); PG8_MMA(0, 1, At, B1); PG8_BAR;
            PG8_LDA(At, 1, 1); PG8_STAGE(PG8_SA(1, 0), a3, voffA);
            PG8_BAR; PG8_WAIT_L(0); PG8_MMA(1, 0, At, B0); PG8_BAR; PG8_SCHED;
            PG8_STAGE(PG8_SB(1, 1), b3 + hstep, voffB);
            PG8_WAIT_V(6); PG8_BAR; PG8_MMA(1, 1, At, B1); PG8_BAR;
            }
        }
        if constexpr (ALIGN_EPI) { if (wr == 0) PG8_BAR; }
        if constexpr (!Epi::AFTER_DRAIN) { E(acc, cur, wr, wc, fr, fq); S.done(cur); }
        if (!has_next) break;
#pragma unroll
        for (int a = 0; a < 2; ++a)
#pragma unroll
            for (int b = 0; b < 2; ++b)
#pragma unroll
                for (int m = 0; m < 4; ++m)
#pragma unroll
                    for (int n = 0; n < 2; ++n) acc[a][b][m][n] = (f32x4){0.f, 0.f, 0.f, 0.f};
        cur = nxt; cA = nA; cB = nB; ++ui;
        if constexpr (ALIGN_EPI) { if (wr == 1) PG8_BAR; }
    }
    PG8_WAIT_V(0);
    if constexpr (!ALIGN_EPI) { if (wr == 0) PG8_BAR; }
    PG8_BAR;
    if constexpr (Epi::AFTER_DRAIN) { E.fused(acc, cur, wr, wc, fr, fq, lds, wid, lane); S.done(cur); }
#undef PG8_SA
#undef PG8_SB
#undef PG8_STAGE
#undef PG8_LDA
#undef PG8_LDB
#undef PG8_MMA
#undef PG8_WAIT_V
#undef PG8_WAIT_L
#undef PG8_BAR
#undef PG8_SCHED
}
}
#define GAS __attribute__((address_space(1)))
#define LAS __attribute__((address_space(3)))
typedef unsigned short bf16;
typedef unsigned v4u __attribute__((ext_vector_type(4)));
typedef float f32x4 __attribute__((ext_vector_type(4)));
typedef short bf16x8 __attribute__((ext_vector_type(8)));
typedef GAS unsigned gu32;
typedef GAS unsigned long long gu64;
#define RLX_AGENT __ATOMIC_RELAXED, __HIP_MEMORY_SCOPE_AGENT
#define LDS_WAIT() asm volatile("s_waitcnt lgkmcnt(0)" ::: "memory")
#define VM_WAIT() asm volatile("s_waitcnt vmcnt(0)" ::: "memory")
__device__ __forceinline__ unsigned long long rt() { return __builtin_amdgcn_s_memrealtime(); }

#define XB_TMO      128
#define XB_XCNT(j)  (256  + 64 * (j))
#define XB_XSUB(j)  (1280 + 64 * (j))
#define XB_XGEN(j)  (2304 + 64 * (j))
#define XB_TOP      3328
#define XB_TOPGEN   3392
#define XCD_BAR_WORDS 3456
#define XB_SPIN_CAP (1u << 18)

__device__ __forceinline__ unsigned xb_ld(unsigned* p)              { return __hip_atomic_load(p, __ATOMIC_RELAXED, __HIP_MEMORY_SCOPE_AGENT); }
__device__ __forceinline__ unsigned xb_add(unsigned* p, unsigned v) { return __hip_atomic_fetch_add(p, v, __ATOMIC_RELAXED, __HIP_MEMORY_SCOPE_AGENT); }
__device__ __forceinline__ unsigned xb_xcc_id() { return (unsigned)__builtin_amdgcn_s_getreg((3 << 11) | 20) & 0xFu; }
#define XB_SPIN(cond, bar) do { unsigned _sp = 0; while (cond) { __builtin_amdgcn_s_sleep(1); \
    if ((++_sp & 255u) == 0u) { if (xb_ld(&(bar)[XB_TMO])) break; if (_sp > XB_SPIN_CAP) { atomicAdd(&(bar)[XB_TMO], 1u); break; } } } } while (0)

struct XcdBarrier {
    unsigned* bar; unsigned x;
    volatile LAS unsigned* st;
};

__device__ __forceinline__ XcdBarrier xcd_barrier_post(unsigned* bar, volatile LAS unsigned* st) {
    XcdBarrier b; b.bar = bar; b.x = xb_xcc_id(); b.st = st;
    if (threadIdx.x == 0) (void)xb_add(&bar[XB_XCNT(b.x)], 1u);
    return b;
}
__device__ __forceinline__ void xcd_barrier_complete(unsigned* bar, unsigned x, unsigned& nloc, unsigned& nx) {
    const unsigned G = gridDim.x * gridDim.y * gridDim.z;
    unsigned sum, cnt, mine, sp = 0u;
    for (;;) {
        sum = 0u; cnt = 0u; mine = 0u;
#pragma unroll
        for (unsigned j = 0; j < 16; ++j) { const unsigned c = xb_ld(&bar[XB_XCNT(j)]); sum += c; cnt += (c > 0u) ? 1u : 0u; mine = (j == x) ? c : mine; }
        if (sum == G) break;
        __builtin_amdgcn_s_sleep(1);
        if ((++sp & 255u) == 0u) { if (xb_ld(&bar[XB_TMO])) break; if (sp > XB_SPIN_CAP) { atomicAdd(&bar[XB_TMO], 1u); break; } }
    }
    nloc = mine > 0u ? mine : 1u; nx = cnt > 0u ? cnt : 1u;
}

__device__ __forceinline__ void xcd_barrier(const XcdBarrier& b, const bool leader_thread) {
    asm volatile("s_waitcnt vmcnt(0)" ::: "memory");
    __syncthreads();
    if (leader_thread) {
        unsigned* bar = b.bar;
        __builtin_amdgcn_s_waitcnt(0);
        unsigned nloc = b.st[0], nx = b.st[1];
        if (nloc == 0u) { xcd_barrier_complete(bar, b.x, nloc, nx); b.st[0] = nloc; b.st[1] = nx; }
        const unsigned old = xb_add(&bar[XB_XSUB(b.x)], 1u);
        const unsigned gen = old / nloc;
        if (old + 1u == (gen + 1u) * nloc) {
            __builtin_amdgcn_fence(__ATOMIC_RELEASE, "agent");
            asm volatile("s_waitcnt vmcnt(0)" ::: "memory");
            const unsigned og = xb_add(&bar[XB_TOP], 1u);
            const unsigned tg = og / nx;
            if (og + 1u == (tg + 1u) * nx) xb_add(&bar[XB_TOPGEN], 1u);
            else XB_SPIN(xb_ld(&bar[XB_TOPGEN]) == tg, bar);
            __builtin_amdgcn_fence(__ATOMIC_ACQUIRE, "agent");
            xb_add(&bar[XB_XGEN(b.x)], 1u);
            asm volatile("s_waitcnt vmcnt(0)" ::: "memory");
        } else {
            XB_SPIN(xb_ld(&bar[XB_XGEN(b.x)]) == gen, bar);
            __builtin_amdgcn_fence(__ATOMIC_ACQUIRE, "agent");
            asm volatile("s_waitcnt vmcnt(0)" ::: "memory");
        }
    }
    __syncthreads();
}
constexpr int NWAVES = 8;
constexpr int MP = 16384, MS = 512, MT = 16896, D = 1024, DFF = 2816, NADA = 9216, NBR = 40;
constexpr float EPS = 1e-6f;
constexpr size_t MiB = 1u << 20;
constexpr size_t WS_CTL = 0, CTL_ZERO_BYTES = 1 * MiB;
constexpr size_t WS_ADAP = 1 * MiB;
constexpr int NKS = 4;
constexpr size_t WS_ADA = 24 * MiB;
constexpr size_t WS_GA = 27 * MiB;
constexpr size_t WS_CARRY = 28 * MiB;
constexpr size_t WS_WFIN = 32 * MiB;
constexpr size_t WS_WFOUT = 76 * MiB;
constexpr size_t WS_WABIN = 98 * MiB;
constexpr size_t WS_WABOUT = 105 * MiB;
constexpr size_t WS_WCIN = 107 * MiB;
constexpr size_t WS_WCOUT = 111 * MiB;
constexpr size_t WS_WGATE = 113 * MiB;
constexpr size_t WS_XN = 114 * MiB;
constexpr size_t WS_BIG = 147 * MiB;
constexpr size_t WS_SLAB = 1 * MiB;
constexpr size_t WS_H2 = 180 * MiB;
constexpr size_t WS_BIAS = 280 * MiB;
constexpr size_t WS_BIASC = 30 * MiB;
constexpr size_t WS_XS3 = 246 * MiB;
constexpr size_t CTL_SSQ = 65536;
constexpr size_t CTL_SCTR = 32768;
constexpr size_t WS_XR = 286 * MiB;
constexpr size_t WS_END = 320 * MiB;
constexpr size_t FIN_ELEMS = (size_t)5632 * 1024, FOUT_ELEMS = (size_t)1024 * 2816, U_ELEMS = (size_t)MT * 512;
constexpr int CW_BAR = 4096;
constexpr size_t O_YP = 0, O_YS = 16777216, O_PAC = 17301504, O_PAN = 17825792, O_PAM = 17829888, O_PBK = 17829920, O_PBV = 19927072, O_PCC = 22024224, O_PCH = 22048800,
                 O_SAC = 22056992, O_SAN = 24154144, O_SAM = 24170528, O_SBK = 24170656, O_SBV = 24432800, O_SCC = 24694944, O_SCH = 24793248, O_TOTAL = 24826016;
constexpr int RING_BYTES = 131072, LDSCTL_OFF = RING_BYTES, MISC_OFF = LDSCTL_OFF + 320, LDS_BYTES = 147456;

typedef short s16x4 __attribute__((ext_vector_type(4)));
typedef unsigned u32x2 __attribute__((ext_vector_type(2)));
using pg8::pk2; using pg8::bidx; using pg8::fast_sigmoid; using pg8::wave_sum; using pg8::wave_max; using pg8::scan_add; using pg8::scan_max; using pg8::qsum; using pg8::qmax; using pg8::bperm; using pg8::rdlane; using pg8::rsum8;
__device__ __forceinline__ float bf2f(unsigned short u) { return __uint_as_float(((unsigned)u) << 16); }
__device__ __forceinline__ float bflo(unsigned w) { return __uint_as_float(w << 16); }
__device__ __forceinline__ float bfhi(unsigned w) { return __uint_as_float(w & 0xffff0000u); }
#define LDS_BARRIER() do { asm volatile("s_waitcnt lgkmcnt(0)" ::: "memory"); __builtin_amdgcn_s_barrier(); asm volatile("" ::: "memory"); } while (0)
__device__ __forceinline__ f32x4 mfma16(bf16x8 a, bf16x8 b, f32x4 c) { return __builtin_amdgcn_mfma_f32_16x16x32_bf16(a, b, c, 0, 0, 0); }
typedef short v4i16_t __attribute__((ext_vector_type(4)));
__device__ __forceinline__ s16x4 ldtr(const LAS unsigned short* p) { return __builtin_bit_cast(s16x4, __builtin_amdgcn_ds_read_tr16_b64_v4i16((LAS v4i16_t*)p)); }
__device__ __forceinline__ bf16x8 cat8(s16x4 a, s16x4 b) { return (bf16x8){a[0], a[1], a[2], a[3], b[0], b[1], b[2], b[3]}; }

#ifndef DUP
#define DUP 0
#endif
#ifndef FOLD
#define FOLD 15
#endif
#ifndef FOLD_RES
#define FOLD_RES FOLD
#endif
#define NREP(k) ((DUP == (k)) ? 2 : 1)
__device__ __forceinline__ void p0_ada_item(const float* cP, const float* cS, const float* adaw, float* part, LAS float* cs, int item, int tid) {
    const int cb = item % 18, ks = item / 18, l = cb / 9, n = (cb % 9) * 1024 + tid * 2, k0 = ks * 128;
    for (int idx = tid; idx < 128 * NBR; idx += 512) { const int b = idx >> 7, kk = idx & 127; const float* c = b < 8 ? cP + b * 1024 : cS + (b - 8) * 1024; cs[kk * NBR + b] = c[k0 + kk]; }
    __syncthreads();
    float ax[NBR], ay[NBR];
#pragma unroll
    for (int b = 0; b < NBR; ++b) { ax[b] = 0.f; ay[b] = 0.f; }
    const float* wp = adaw + ((size_t)l * 1024 + k0) * NADA + n;
    float2 wn[16];
#pragma unroll
    for (int j = 0; j < 16; ++j) wn[j] = *(const float2*)(wp + (size_t)j * NADA);
    for (int k8 = 0; k8 < 128; k8 += 16) {
        float2 wc[16];
#pragma unroll
        for (int j = 0; j < 16; ++j) wc[j] = wn[j];
        if (k8 + 16 < 128) {
#pragma unroll
            for (int j = 0; j < 16; ++j) wn[j] = *(const float2*)(wp + (size_t)(k8 + 16 + j) * NADA); }
#pragma unroll
        for (int j = 0; j < 16; ++j) { const LAS f32x4* c4 = (const LAS f32x4*)(cs + (k8 + j) * NBR);
#pragma unroll
            for (int b4 = 0; b4 < NBR / 4; ++b4) { const f32x4 cv = c4[b4];
#pragma unroll
                for (int e = 0; e < 4; ++e) { ax[4 * b4 + e] += cv[e] * wc[j].x; ay[4 * b4 + e] += cv[e] * wc[j].y; } } } }
    float* pp = part + ((size_t)(ks * 2 + l) * NBR) * NADA + n;
#pragma unroll
    for (int b = 0; b < NBR; ++b) *(float2*)(pp + (size_t)b * NADA) = make_float2(ax[b], ay[b]);
    __syncthreads();
}
__device__ __forceinline__ void p0_ada_mfma(const float* cP, const float* cS, const float* adaw, float* part, LAS unsigned char* lds, int wg, int tid) {
    const int lane = tid & 63, w = __builtin_amdgcn_readfirstlane(tid >> 6), li = lane & 15, q = lane >> 4;
    const int kq = wg >> 6;
    LAS unsigned short* csh = (LAS unsigned short*)lds; LAS unsigned short* csl = csh + 48 * 264;
    LDS_BARRIER();
    { f32x4 v[5];
#pragma unroll
      for (int j = 0; j < 5; ++j) { const int i = tid + 512 * j, b = i >> 6, c4 = i & 63; const float* c = b < 8 ? cP + b * 1024 : cS + (b - 8) * 1024; v[j] = *(const f32x4*)(c + 256 * kq + 4 * c4); }
#pragma unroll
      for (int j = 0; j < 5; ++j) { const int i = tid + 512 * j, b = i >> 6, c4 = i & 63; u32x2 h, l; h.x = pk2(v[j][0], v[j][1]); h.y = pk2(v[j][2], v[j][3]);
          l.x = pk2(v[j][0] - bflo(h.x), v[j][1] - bfhi(h.x)); l.y = pk2(v[j][2] - bflo(h.y), v[j][3] - bfhi(h.y));
          *(LAS u32x2*)(csh + b * 264 + 4 * c4) = h; *(LAS u32x2*)(csl + b * 264 + 4 * c4) = l; } }
    LDS_BARRIER();
    for (int it = w; it < 18; it += NWAVES) {
        const int t = (18 * wg + it) % 1152, l = t / 576, n0 = (t % 576) * 16;
        const float* wp = adaw + ((size_t)l * 1024 + 256 * kq) * NADA + n0;
        const unsigned voff = (unsigned)(8 * q * NADA + li);
        float wv[8][8];
#pragma unroll
        for (int ks = 0; ks < 8; ++ks)
#pragma unroll
            for (int j = 0; j < 8; ++j) { const GAS float* rp = (const GAS float*)(wp + (size_t)(32 * ks + j) * NADA); asm volatile("" : "+s"(rp)); wv[ks][j] = rp[voff]; }
        f32x4 acc[3];
#pragma unroll
        for (int bt = 0; bt < 3; ++bt) acc[bt] = (f32x4){0.f, 0.f, 0.f, 0.f};
#pragma unroll
        for (int ks = 0; ks < 8; ++ks) {
            v4u hi, lo; hi.x = pk2(wv[ks][0], wv[ks][1]); hi.y = pk2(wv[ks][2], wv[ks][3]); hi.z = pk2(wv[ks][4], wv[ks][5]); hi.w = pk2(wv[ks][6], wv[ks][7]);
            lo.x = pk2(wv[ks][0] - bflo(hi.x), wv[ks][1] - bfhi(hi.x)); lo.y = pk2(wv[ks][2] - bflo(hi.y), wv[ks][3] - bfhi(hi.y));
            lo.z = pk2(wv[ks][4] - bflo(hi.z), wv[ks][5] - bfhi(hi.z)); lo.w = pk2(wv[ks][6] - bflo(hi.w), wv[ks][7] - bfhi(hi.w));
            const bf16x8 ah = __builtin_bit_cast(bf16x8, hi), al = __builtin_bit_cast(bf16x8, lo);
#pragma unroll
            for (int bt = 0; bt < 3; ++bt) { const int bo = (16 * bt + li) * 264 + 32 * ks + 8 * q;
                const bf16x8 bh = *(const LAS bf16x8*)(csh + bo), bl = *(const LAS bf16x8*)(csl + bo);
                acc[bt] = mfma16(ah, bh, acc[bt]); acc[bt] = mfma16(al, bh, acc[bt]); acc[bt] = mfma16(ah, bl, acc[bt]); } }
#pragma unroll
        for (int bt = 0; bt < 3; ++bt) { const int b = 16 * bt + li;
            if (b < NBR) *(f32x4*)(part + ((size_t)(kq * 2 + l) * NBR + b) * NADA + n0 + 4 * q) = acc[bt]; }
    }
}
struct Args { const float* in[34]; float* out; unsigned char* ws; };
struct Ctx { float* out; unsigned char* ws; };
__device__ __forceinline__ const float* inptr(int i) {
    const float* const __attribute__((address_space(4)))* p = (const float* const __attribute__((address_space(4)))*)__builtin_amdgcn_kernarg_segment_ptr();
    asm volatile("" : "+s"(p));
    return (const float*)(const GAS float*)p[i]; }
constexpr int TR_IFIN = 16 * 176, TR_IFOUT = 44 * 32, TR_IABIN = 16 * 112, TR_ISQ = 16 * 32, TR_ICIN = 16 * 64, TR_IGATE = 8 * 16;
__device__ __forceinline__ int tr_count(int st) { return st == 0 ? TR_IFIN + TR_IFOUT : st == 1 ? TR_IABIN + TR_ISQ : st == 2 ? TR_IFIN + TR_IFOUT : 2 * TR_IFIN + 2 * TR_IFOUT + TR_ICIN + TR_ISQ + TR_IGATE; }
__device__ __forceinline__ void tr_fin(int r, int f, unsigned char* ws, const float*& W, unsigned short*& WT, int& ldw, int& c0, int& k0, int& r0, int& Kd, float& wsc) {
    const int kb = r / 176, nb = r % 176, n0 = 32 * nb;
    W = inptr((f >> 1) ? 16 : 12) + (size_t)(f & 1) * 1024 * 5632; ldw = 5632; c0 = n0; k0 = 64 * kb; WT = (unsigned short*)(ws + WS_WFIN) + (size_t)f * FIN_ELEMS; Kd = 1024;
    r0 = n0 < DFF ? 256 * (n0 >> 7) + (n0 & 127) : 256 * ((n0 - DFF) >> 7) + 128 + ((n0 - DFF) & 127);
    wsc = n0 < DFF ? -1.4426950408889634f : -0.6931471805599453f; }
__device__ __forceinline__ void tr_fout(int r, int f, unsigned char* ws, const float*& W, unsigned short*& WT, int& ldw, int& c0, int& k0, int& r0, int& Kd) {
    const int kb = r / 32, nb = r % 32;
    W = inptr((f >> 1) ? 17 : 13) + (size_t)(f & 1) * DFF * 1024; ldw = 1024; c0 = 32 * nb; k0 = 64 * kb; WT = (unsigned short*)(ws + WS_WFOUT) + (size_t)f * FOUT_ELEMS; r0 = 32 * nb; Kd = DFF; }
__device__ __forceinline__ void tr_decode(int it, int st, unsigned char* ws, const float*& W, unsigned short*& WT, int& ldw, int& c0, int& k0, int& r0, int& Kd, float& wsc) {
    int r = it; wsc = 1.0f;
    if (st == 0 || st == 2) { const int f = st;
        if (r < TR_IFIN) { tr_fin(r, f, ws, W, WT, ldw, c0, k0, r0, Kd, wsc); return; }
        tr_fout(r - TR_IFIN, f, ws, W, WT, ldw, c0, k0, r0, Kd); return; }
    if (st == 1) {
        if (r < TR_IABIN) { const int kb = r / 112, nb = r % 112, L0 = 32 * nb, l = L0 & 255;
            W = inptr(20); ldw = 3592; c0 = L0 < 2048 ? L0 : L0 + 8; k0 = 64 * kb; WT = (unsigned short*)(ws + WS_WABIN); r0 = 256 * (L0 >> 8) + 128 * ((l >> 5) & 1) + 32 * (l >> 6); Kd = 1024; return; }
        r -= TR_IABIN;
        W = inptr(26); ldw = 1024; c0 = 32 * (r % 32); k0 = 64 * (r / 32); WT = (unsigned short*)(ws + WS_WABOUT); r0 = c0; Kd = 1024; return; }
    if (r < 2 * TR_IFIN) { tr_fin(r % TR_IFIN, 2 * (r / TR_IFIN) + 1, ws, W, WT, ldw, c0, k0, r0, Kd, wsc); return; }
    r -= 2 * TR_IFIN;
    if (r < 2 * TR_IFOUT) { tr_fout(r % TR_IFOUT, 2 * (r / TR_IFOUT) + 1, ws, W, WT, ldw, c0, k0, r0, Kd); return; }
    r -= 2 * TR_IFOUT;
    if (r < TR_ICIN) { W = inptr(27); ldw = 2048; c0 = 32 * (r % 64); k0 = 64 * (r / 64); WT = (unsigned short*)(ws + WS_WCIN); r0 = c0; Kd = 1024; return; }
    r -= TR_ICIN;
    if (r < TR_ISQ) { W = inptr(33); ldw = 1024; c0 = 32 * (r % 32); k0 = 64 * (r / 32); WT = (unsigned short*)(ws + WS_WCOUT); r0 = c0; Kd = 1024; return; }
    r -= TR_ISQ;
    { const int blk = r >> 4, kb = (r >> 3) & 1, nb = r & 7;
      W = inptr(30) + (size_t)blk * 128 * 256; ldw = 256; c0 = 32 * nb; k0 = 64 * kb; WT = (unsigned short*)(ws + WS_WGATE) + (size_t)blk * 256 * 128; r0 = c0; Kd = 128; }
}
__device__ __forceinline__ void p0_weights(const Ctx& A, LAS float* scr, int st, int gw, int NGW, int lane) {
    unsigned char* ws = A.ws;
    const int NITEMS = tr_count(st);
    const float* W; unsigned short* WT; int ldw, c0, k0, r0, Kd; float wsc;
    float cur[32], nxt[32];
    int it = gw;
    if (it < NITEMS) { tr_decode(it, st, ws, W, WT, ldw, c0, k0, r0, Kd, wsc);
#pragma unroll
        for (int i = 0; i < 32; ++i) nxt[i] = W[(size_t)(k0 + 2 * i + (lane >> 5)) * ldw + c0 + (lane & 31)]; }
    for (; it < NITEMS; it += NGW) {
        unsigned short* WTc = WT; const int r0c = r0, Kdc = Kd, k0c = k0; const float wscc = wsc;
#pragma unroll
        for (int i = 0; i < 32; ++i) cur[i] = nxt[i];
        if (it + NGW < NITEMS) { tr_decode(it + NGW, st, ws, W, WT, ldw, c0, k0, r0, Kd, wsc);
#pragma unroll
            for (int i = 0; i < 32; ++i) nxt[i] = W[(size_t)(k0 + 2 * i + (lane >> 5)) * ldw + c0 + (lane & 31)]; }
#pragma unroll
        for (int i = 0; i < 32; ++i) scr[(2 * i + (lane >> 5)) * 33 + (lane & 31)] = cur[i] * wscc;
        LDS_WAIT(); asm volatile("" ::: "memory");
        const int c = lane & 7;
#pragma unroll
        for (int j = 0; j < 4; ++j) { const int n = (lane >> 3) + 8 * j; const LAS float* s = scr + (8 * c) * 33 + n;
            v4u o; o.x = pk2(s[0 * 33], s[1 * 33]); o.y = pk2(s[2 * 33], s[3 * 33]); o.z = pk2(s[4 * 33], s[5 * 33]); o.w = pk2(s[6 * 33], s[7 * 33]);
            *(GAS v4u*)(WTc + (size_t)(r0c + n) * Kdc + k0c + 8 * c) = o; }
        LDS_WAIT(); asm volatile("" ::: "memory");
    }
}

template <bool GATES, bool PLDS>
__device__ __forceinline__ void norm_row(f32x4 (&v)[4], int row, const float* nw, const float* adaL, int j3, unsigned short* XN, const float* gbias, float* GA, const LAS float* wg, const LAS float* pl, int lane) {
    f32x4 g[4], s1[4], s0[4];
    if (PLDS) {
#pragma unroll
        for (int j = 0; j < 4; ++j) { const int col = j * 256 + lane * 4; g[j] = *(const LAS f32x4*)(pl + col); s0[j] = *(const LAS f32x4*)(pl + 1024 + col); s1[j] = (f32x4){0.f, 0.f, 0.f, 0.f}; }
    } else {
        const int b = bidx(row); const float* sh = adaL + (size_t)b * NADA + j3 * 1024; const float* sc = sh + 1024;
#pragma unroll
        for (int j = 0; j < 4; ++j) { const int col = j * 256 + lane * 4; g[j] = *(const f32x4*)(nw + col); s1[j] = *(const f32x4*)(sc + col); s0[j] = *(const f32x4*)(sh + col); } }
    float ss = 0.f;
#pragma unroll
    for (int j = 0; j < 4; ++j) ss += (v[j][0] * v[j][0] + v[j][1] * v[j][1]) + (v[j][2] * v[j][2] + v[j][3] * v[j][3]);
    const float rstd = 1.0f / sqrtf(wave_sum(ss) * (1.0f / D) + EPS);
    float ga[8];
#pragma unroll
    for (int e = 0; e < 8; ++e) ga[e] = 0.f;
#pragma unroll
    for (int j = 0; j < 4; ++j) { const int col = j * 256 + lane * 4;
        const f32x4 y = v[j] * rstd * g[j] * (s1[j] + 1.0f) + s0[j];
        u32x2 o; o.x = pk2(y[0], y[1]); o.y = pk2(y[2], y[3]);
        *(u32x2*)(XN + (size_t)row * D + col) = o;
        if (GATES) {
#pragma unroll
            for (int e = 0; e < 4; ++e) { const f32x4 w0 = *(const LAS f32x4*)(wg + (col + e) * 8), w1 = *(const LAS f32x4*)(wg + (col + e) * 8 + 4);
                ga[0] += y[e] * w0[0]; ga[1] += y[e] * w0[1]; ga[2] += y[e] * w0[2]; ga[3] += y[e] * w0[3];
                ga[4] += y[e] * w1[0]; ga[5] += y[e] * w1[1]; ga[6] += y[e] * w1[2]; ga[7] += y[e] * w1[3]; }
            __builtin_amdgcn_sched_barrier(0); }
    }
    if (GATES) {
#pragma unroll
        for (int e = 0; e < 8; ++e) ga[e] = wave_sum(ga[e]);
        if (lane < 8) { float x = ga[0];
#pragma unroll
            for (int e = 1; e < 8; ++e) x = (lane == e) ? ga[e] : x;
            x += gbias[lane];
            if (lane >= 4) x = fminf(x, 0.f) - log1pf(expf(-fabsf(x)));
            GA[(size_t)row * 8 + lane] = x; }
    }
}
__device__ __forceinline__ void ld_xh(f32x4 (&v)[4], const unsigned short* xrow, int lane) {
#pragma unroll
    for (int j = 0; j < 4; ++j) { const u32x2 w = *(const u32x2*)(xrow + j * 256 + lane * 4); v[j] = (f32x4){bflo(w.x), bfhi(w.x), bflo(w.y), bfhi(w.y)}; }
}
__device__ __forceinline__ void fix_row(f32x4 (&v)[4], int row, const float* xs, unsigned short* xh, const float* fx_slab, int fx_npart, bool base_f32, const float* fx_gate, float fx_s, float* outf, int lane) {
    const int r = row - MP;
    if (fx_npart == 0) {
#pragma unroll
        for (int j = 0; j < 4; ++j) v[j] = *(const f32x4*)(xs + (size_t)r * D + j * 256 + lane * 4);
        return; }
    const float* gp = fx_gate + (size_t)bidx(row) * NADA;
    f32x4 bs[4];
    if (base_f32) {
#pragma unroll
        for (int j = 0; j < 4; ++j) bs[j] = *(const f32x4*)(xs + (size_t)r * D + j * 256 + lane * 4); }
    else ld_xh(bs, xh + (size_t)row * D, lane);
#pragma unroll
    for (int j = 0; j < 4; ++j) { const int col = j * 256 + lane * 4; f32x4 pv[11];
#pragma unroll
        for (int p = 0; p < 11; ++p) { const int pc = p < fx_npart ? p : 0; pv[p] = *(const f32x4*)(fx_slab + ((size_t)pc * 512 + r) * 1024 + col); }
        f32x4 a = {0.f, 0.f, 0.f, 0.f};
#pragma unroll
        for (int p = 0; p < 11; ++p) a = a + pv[p] * (p < fx_npart ? 1.0f : 0.0f);
        v[j] = bs[j] + (*(const f32x4*)(gp + col) * fx_s) * a;
        if (outf) *(f32x4*)(outf + (size_t)row * D + col) = v[j];
        else { u32x2 o; o.x = pk2(v[j][0], v[j][1]); o.y = pk2(v[j][2], v[j][3]); *(u32x2*)(xh + (size_t)row * D + col) = o;
            v[j] = (f32x4){bflo(o.x), bfhi(o.x), bflo(o.y), bfhi(o.y)}; } }
}
template <bool GATES>
__device__ __forceinline__ void norm_phase(const float* xp, const float* xs, unsigned short* xh, bool x_f32, const float* nw, const float* adaL, int j3, unsigned short* XN,
                                           const float* wg_src  , const float* gbias, float* GA, LAS float* wg, const float* fx_slab, int fx_npart, bool fx_base_f32, const float* fx_gate, float fx_s, bool probe_pass, const float* adap  , const float* adab, float* ada_out, int gw_, int NGW_, int lane_, int tid_) {
    if (GATES) {
        for (int i = tid_; i < 1024 * 8; i += 512) wg[i] = wg_src[(size_t)(i >> 3) * 3592 + 2048 + (i & 7)];
        __syncthreads();
    }
    if (adap) {
        for (int i = (gw_ / NWAVES) * 512 + tid_; i < 2 * NBR * NADA / 4; i += (NGW_ / NWAVES) * 512) { const int e = i * 4, l = e / (NBR * NADA), n = e % NADA;
            f32x4 s = *(const f32x4*)(adab + (size_t)l * NADA + n);
#pragma unroll
            for (int ks = 0; ks < NKS; ++ks) s = s + *(const f32x4*)(adap + (size_t)ks * 2 * NBR * NADA + e);
            *(f32x4*)(ada_out + e) = s; } }
    f32x4 v[4];
    LAS float* pl = wg + 8192;
    const int vcu_ = gw_ / NWAVES, wv_ = gw_ % NWAVES, G_ = NGW_ / NWAVES;
    const bool sq = !adap && !probe_pass && G_ == 256;
    const int srow = 2 * vcu_ + (wv_ >> 2), scol = 256 * (wv_ & 3) + 4 * lane_, sb = 8 + (srow >> 4);
    f32x4 q_part[11], q_gate, q_nw, q_sc, q_sh, q_basef; u32x2 q_baseh;
    if (sq) {
#pragma unroll
        for (int p = 0; p < 11; ++p) { const int pc = p < fx_npart ? p : 0; q_part[p] = *(const f32x4*)(fx_slab + ((size_t)pc * 512 + srow) * 1024 + scol); }
        q_gate = *(const f32x4*)(fx_gate + (size_t)sb * NADA + scol); q_nw = *(const f32x4*)(nw + scol);
        q_sh = *(const f32x4*)(adaL + (size_t)sb * NADA + j3 * 1024 + scol); q_sc = *(const f32x4*)(adaL + (size_t)sb * NADA + j3 * 1024 + 1024 + scol);
        q_basef = *(const f32x4*)(xs + (size_t)srow * D + scol);
        q_baseh = *(const u32x2*)(xh + (size_t)(MP + srow) * D + scol); }
    for (int bl = vcu_; bl < MP / 64 + (adap ? 32 : 0); bl += G_) {
        const bool sblk = bl >= MP / 64;
        const int b = sblk ? 8 + (bl - MP / 64) : bl >> 5; const float* sh = adaL + (size_t)b * NADA + j3 * 1024; const float* sc = sh + 1024;
        __syncthreads();
        for (int i = tid_; i < 256; i += 512) { const f32x4 g4 = *(const f32x4*)(nw + 4 * i); f32x4 s14, s04;
            if (adap) { const size_t o = (size_t)b * NADA + j3 * 1024 + 4 * i; s04 = *(const f32x4*)(adab + j3 * 1024 + 4 * i); s14 = *(const f32x4*)(adab + j3 * 1024 + 1024 + 4 * i);
#pragma unroll
                for (int ks = 0; ks < NKS; ++ks) { s04 = s04 + *(const f32x4*)(adap + (size_t)ks * 2 * NBR * NADA + o); s14 = s14 + *(const f32x4*)(adap + (size_t)ks * 2 * NBR * NADA + o + 1024); } }
            else { s14 = *(const f32x4*)(sc + 4 * i); s04 = *(const f32x4*)(sh + 4 * i); }
            *(LAS f32x4*)(pl + 4 * i) = g4 * (s14 + 1.0f); *(LAS f32x4*)(pl + 1024 + 4 * i) = s04; }
        __syncthreads();
        if (sblk) {
            for (int r = 0; r < 2; ++r) { const int row = MP + 16 * (bl - MP / 64) + 2 * wv_ + r;
#pragma unroll
                for (int j = 0; j < 4; ++j) v[j] = *(const f32x4*)(xs + (size_t)(row - MP) * D + j * 256 + lane_ * 4);
                norm_row<GATES, true>(v, row, nw, adaL, j3, XN, gbias, GA, wg, pl, lane_); }
            continue; }
        const int rb = 64 * bl + 8 * wv_;
        if (x_f32) {
            f32x4 vn[4];
#pragma unroll
            for (int j = 0; j < 4; ++j) vn[j] = *(const f32x4*)(xp + (size_t)rb * D + j * 256 + lane_ * 4);
            for (int r = 0; r < 8; ++r) {
#pragma unroll
                for (int j = 0; j < 4; ++j) v[j] = vn[j];
                const int rn = rb + (r < 7 ? r + 1 : r);
#pragma unroll
                for (int j = 0; j < 4; ++j) vn[j] = *(const f32x4*)(xp + (size_t)rn * D + j * 256 + lane_ * 4);
                norm_row<GATES, true>(v, rb + r, nw, adaL, j3, XN, gbias, GA, wg, pl, lane_); }
        } else {
            u32x2 wn[4];
#pragma unroll
            for (int j = 0; j < 4; ++j) wn[j] = *(const u32x2*)(xh + (size_t)rb * D + j * 256 + lane_ * 4);
            for (int r = 0; r < 8; ++r) {
#pragma unroll
                for (int j = 0; j < 4; ++j) v[j] = (f32x4){bflo(wn[j].x), bfhi(wn[j].x), bflo(wn[j].y), bfhi(wn[j].y)};
                const int rn = rb + (r < 7 ? r + 1 : r);
#pragma unroll
                for (int j = 0; j < 4; ++j) wn[j] = *(const u32x2*)(xh + (size_t)rn * D + j * 256 + lane_ * 4);
                norm_row<GATES, true>(v, rb + r, nw, adaL, j3, XN, gbias, GA, wg, pl, lane_); }
        }
    }
    if (sq) {
        LAS float* red = pl + 2048;
        f32x4 a = {0.f, 0.f, 0.f, 0.f};
#pragma unroll
        for (int p = 0; p < 11; ++p) a = a + q_part[p] * (p < fx_npart ? 1.0f : 0.0f);
        const f32x4 bs = fx_base_f32 ? q_basef : (f32x4){bflo(q_baseh.x), bfhi(q_baseh.x), bflo(q_baseh.y), bfhi(q_baseh.y)};
        f32x4 xv = bs + (q_gate * fx_s) * a;
        { u32x2 o; o.x = pk2(xv[0], xv[1]); o.y = pk2(xv[2], xv[3]); *(u32x2*)(xh + (size_t)(MP + srow) * D + scol) = o; xv = (f32x4){bflo(o.x), bfhi(o.x), bflo(o.y), bfhi(o.y)}; }
        const float ssq = wave_sum((xv[0] * xv[0] + xv[1] * xv[1]) + (xv[2] * xv[2] + xv[3] * xv[3]));
        __syncthreads();
        if (lane_ == 0) red[wv_] = ssq;
        __syncthreads();
        const int w0 = wv_ & 4; const float rstd = 1.0f / sqrtf(((red[w0] + red[w0 + 1]) + (red[w0 + 2] + red[w0 + 3])) * (1.0f / D) + EPS);
        const f32x4 y = xv * rstd * q_nw * (q_sc + 1.0f) + q_sh;
        { u32x2 o; o.x = pk2(y[0], y[1]); o.y = pk2(y[2], y[3]); *(u32x2*)(XN + (size_t)(MP + srow) * D + scol) = o; }
        if (GATES) { float ga[8];
#pragma unroll
            for (int e = 0; e < 8; ++e) ga[e] = 0.f;
#pragma unroll
            for (int c = 0; c < 4; ++c) { const f32x4 w0v = *(const LAS f32x4*)(wg + (scol + c) * 8), w1v = *(const LAS f32x4*)(wg + (scol + c) * 8 + 4);
                ga[0] += y[c] * w0v[0]; ga[1] += y[c] * w0v[1]; ga[2] += y[c] * w0v[2]; ga[3] += y[c] * w0v[3]; ga[4] += y[c] * w1v[0]; ga[5] += y[c] * w1v[1]; ga[6] += y[c] * w1v[2]; ga[7] += y[c] * w1v[3]; }
#pragma unroll
            for (int e = 0; e < 8; ++e) ga[e] = wave_sum(ga[e]);
            __syncthreads();
            if (lane_ < 8) { float x = ga[0];
#pragma unroll
                for (int e = 1; e < 8; ++e) x = (lane_ == e) ? ga[e] : x;
                red[8 + wv_ * 8 + lane_] = x; }
            __syncthreads();
            if ((wv_ & 3) == 0 && lane_ < 8) { float x = (red[8 + wv_ * 8 + lane_] + red[8 + (wv_ + 1) * 8 + lane_]) + (red[8 + (wv_ + 2) * 8 + lane_] + red[8 + (wv_ + 3) * 8 + lane_]) + gbias[lane_];
                if (lane_ >= 4) x = fminf(x, 0.f) - log1pf(expf(-fabsf(x)));
                GA[(size_t)(MP + srow) * 8 + lane_] = x; } }
    }
    else if (!probe_pass && !adap) for (int row = MP + gw_; row < MT; row += NGW_) { fix_row(v, row, xs, xh, fx_slab, fx_npart, fx_base_f32, fx_gate, fx_s, nullptr, lane_); norm_row<GATES, false>(v, row, nw, adaL, j3, XN, gbias, GA, wg, nullptr, lane_); }
}

__device__ __forceinline__ void bias_wg(const unsigned short* WT, const float* shb, float* bias, LAS unsigned char* lds, int wgi, int nwg, int tid, int npairs = 176, int ldb = 5632) {
    const int lane = tid & 63, w = __builtin_amdgcn_readfirstlane(tid >> 6), li = lane & 15, q = lane >> 4;
    if (wgi >= npairs) return;
    LAS unsigned short* shs = (LAS unsigned short*)lds; LAS float* scr = (LAS float*)(lds + 99072);
    LDS_BARRIER();
    { f32x4 v[20];
#pragma unroll
      for (int j = 0; j < 20; ++j) { const int i = tid + 512 * j; v[j] = *(const f32x4*)(shb + (size_t)(i >> 8) * NADA + 4 * (i & 255)); }
#pragma unroll
      for (int j = 0; j < 20; ++j) { const int i = tid + 512 * j; u32x2 o; o.x = pk2(v[j][0], v[j][1]); o.y = pk2(v[j][2], v[j][3]); *(LAS u32x2*)(shs + (i >> 8) * 1032 + 4 * (i & 255)) = o; } }
    LDS_BARRIER();
    for (int pair = wgi; pair < npairs; pair += nwg) {
        const int n0 = 16 * (2 * pair + (w >> 2)), kq = w & 3;
        bf16x8 a[8];
#pragma unroll
        for (int ks = 0; ks < 8; ++ks) a[ks] = *(const bf16x8*)(WT + (size_t)(n0 + li) * 1024 + 256 * kq + 32 * ks + 8 * q);
        f32x4 acc[3];
#pragma unroll
        for (int bt = 0; bt < 3; ++bt) acc[bt] = (f32x4){0.f, 0.f, 0.f, 0.f};
#pragma unroll
        for (int ks = 0; ks < 8; ++ks)
#pragma unroll
            for (int bt = 0; bt < 3; ++bt) acc[bt] = mfma16(a[ks], *(const LAS bf16x8*)(shs + (16 * bt + li) * 1032 + 256 * kq + 32 * ks + 8 * q), acc[bt]);
        LDS_BARRIER();
#pragma unroll
        for (int bt = 0; bt < 3; ++bt) *(LAS f32x4*)(scr + ((w * 3 + bt) * 64 + lane) * 4) = acc[bt];
        LDS_BARRIER();
        if (kq == 0) {
#pragma unroll
            for (int bt = 0; bt < 3; ++bt) { f32x4 t = *(const LAS f32x4*)(scr + ((w * 3 + bt) * 64 + lane) * 4);
#pragma unroll
                for (int j = 1; j < 4; ++j) t = t + *(const LAS f32x4*)(scr + (((w + j) * 3 + bt) * 64 + lane) * 4);
                const int b = 16 * bt + li;
                if (b < NBR) *(f32x4*)(bias + (size_t)b * ldb + n0 + 4 * q) = t; } }
    }
}
__device__ __forceinline__ void sample_fold(unsigned short* xh, const float* slab, int npart, const float* gate, float fs, const float* nw, const float* adaL, int j3, unsigned short* XS, LAS float* red, unsigned* ctr, int li, int nl, int tid) {
    const int lane = tid & 63, wv = __builtin_amdgcn_readfirstlane(tid >> 6);
    const int scol = 256 * (wv & 3) + 4 * lane;
    f32x4 part[11], g4, sh4, sc4; u32x2 bh;
#define SF_LOAD(rp_) do { const int rpc_ = (rp_) < 256 ? (rp_) : 255, sr_ = 2 * rpc_ + (wv >> 2), sb_ = 8 + (sr_ >> 4); \
        _Pragma("unroll") for (int p = 0; p < 11; ++p) { const int pc = p < npart ? p : 0; part[p] = *(const f32x4*)(slab + ((size_t)pc * 512 + sr_) * 1024 + scol); } \
        g4 = *(const f32x4*)(gate + (size_t)sb_ * NADA + scol); sh4 = *(const f32x4*)(adaL + (size_t)sb_ * NADA + j3 * 1024 + scol); sc4 = *(const f32x4*)(adaL + (size_t)sb_ * NADA + j3 * 1024 + 1024 + scol); \
        bh = *(const u32x2*)(xh + (size_t)(MP + sr_) * D + scol); } while (0)
    const f32x4 n4 = *(const f32x4*)(nw + scol);
    SF_LOAD(li);
    for (int rp = li; rp < 256; rp += nl) {
        const int srow = 2 * rp + (wv >> 2);
        f32x4 a = {0.f, 0.f, 0.f, 0.f};
#pragma unroll
        for (int p = 0; p < 11; ++p) a = a + part[p] * (p < npart ? 1.0f : 0.0f);
        f32x4 xv = (f32x4){bflo(bh.x), bfhi(bh.x), bflo(bh.y), bfhi(bh.y)} + (g4 * fs) * a;
        const f32x4 mul4 = n4 * (sc4 + 1.0f), add4 = sh4;
        SF_LOAD(rp + nl);
        { u32x2 o; o.x = pk2(xv[0], xv[1]); o.y = pk2(xv[2], xv[3]); __hip_atomic_store((unsigned long long*)(xh + (size_t)(MP + srow) * D + scol), ((unsigned long long)o.y << 32) | o.x, __ATOMIC_RELAXED, __HIP_MEMORY_SCOPE_AGENT);
          xv = (f32x4){bflo(o.x), bfhi(o.x), bflo(o.y), bfhi(o.y)}; }
        const float ssq = wave_sum((xv[0] * xv[0] + xv[1] * xv[1]) + (xv[2] * xv[2] + xv[3] * xv[3]));
        LDS_BARRIER();
        if (lane == 0) red[wv] = ssq;
        LDS_BARRIER();
        const int w0 = wv & 4; const float rstd = 1.0f / sqrtf(((red[w0] + red[w0 + 1]) + (red[w0 + 2] + red[w0 + 3])) * (1.0f / D) + EPS);
        const f32x4 y = xv * rstd * mul4 + add4;
        { u32x2 o; o.x = pk2(y[0], y[1]); o.y = pk2(y[2], y[3]); __hip_atomic_store((unsigned long long*)(XS + (size_t)(MP + srow) * D + scol), ((unsigned long long)o.y << 32) | o.x, __ATOMIC_RELAXED, __HIP_MEMORY_SCOPE_AGENT); }
    }
#undef SF_LOAD
    VM_WAIT();
    __syncthreads();
    if (tid == 0) (void)__hip_atomic_fetch_add(ctr, 1u, __ATOMIC_RELAXED, __HIP_MEMORY_SCOPE_AGENT);
}

constexpr int ML_Q = 0, ML_K = 17408, ML_V = 34816, ML_KW = 52224, ML_S = 69632, ML_CT = 78848, ML_TAB = 113664;
constexpr int MLP = 136, MSP = 72;

__device__ __forceinline__ void mlstm_seq(LAS unsigned char* lds, const unsigned short* QA, const unsigned short* KA, const unsigned short* VA, const unsigned short* OA, const float* GA,
                                          unsigned short* MIX, const float* gnorm, int rowbase, int h, int nchunk, int L,
                                          const float* C0, const float* n0, const float* m0p, float* Cout, float* nout, float* mout, int tid) {
    const int lane = tid & 63, w = __builtin_amdgcn_readfirstlane(tid >> 6), li = lane & 15, q = lane >> 4, qq = li >> 2, pp = li & 3;
    LAS unsigned short* Qs = (LAS unsigned short*)(lds + ML_Q); LAS unsigned short* Ks = (LAS unsigned short*)(lds + ML_K);
    LAS unsigned short* Vs = (LAS unsigned short*)(lds + ML_V); LAS unsigned short* Kws = (LAS unsigned short*)(lds + ML_KW);
    LAS unsigned short* Ss = (LAS unsigned short*)(lds + ML_S); LAS unsigned short* CT = (LAS unsigned short*)(lds + ML_CT);
    LAS float* nS = (LAS float*)(lds + ML_TAB); LAS float* qnS = nS + 128; LAS float* SpS = qnS + 64; LAS float* ssS = SpS + 256;
    LDS_BARRIER();
    f32x4 accC[8];
    if (C0) {
#pragma unroll
        for (int i = 0; i < 8; ++i)
#pragma unroll
            for (int r = 0; r < 4; ++r) accC[i][r] = C0[(size_t)(16 * i + 4 * q + r) * 128 + 16 * w + li];
    } else {
#pragma unroll
        for (int i = 0; i < 8; ++i) accC[i] = (f32x4){0.f, 0.f, 0.f, 0.f}; }
#pragma unroll
    for (int i = 0; i < 8; ++i) {
        u32x2 o; o.x = pk2(accC[i][0], accC[i][1]); o.y = pk2(accC[i][2], accC[i][3]);
        *(LAS u32x2*)(CT + (16 * w + li) * MLP + 16 * i + 4 * q) = o; }
    float m = m0p ? *m0p : 0.f;
    if (tid < 128) nS[tid] = n0 ? n0[tid] : 0.f;
    v4u pq[2], pk[2], pv[2];
    const v4u zero4 = {0u, 0u, 0u, 0u};
#pragma unroll
    for (int c2 = 0; c2 < 2; ++c2) { const int ci = tid + 512 * c2, r = ci >> 4, c16 = ci & 15; const size_t off = (size_t)(rowbase + r) * 512 + h * 128 + 8 * c16;
        if (r < L) { pq[c2] = *(const v4u*)(QA + off); pk[c2] = *(const v4u*)(KA + off); pv[c2] = *(const v4u*)(VA + off); } else { pq[c2] = zero4; pk[c2] = zero4; pv[c2] = zero4; } }
    const bool valid = lane < L; const int lcl = valid ? lane : L - 1;
    float ign = GA[(size_t)(rowbase + lcl) * 8 + h], lfn = GA[(size_t)(rowbase + lcl) * 8 + 4 + h];
    for (int ch = 0; ch < nchunk; ++ch) {
        const int row0 = rowbase + ch * 64;
        u32x2 ovp[4];
#pragma unroll
        for (int lt = 0; lt < 4; ++lt) { const int l = 16 * lt + li, lc = l < L ? l : L - 1; ovp[lt] = *(const u32x2*)(OA + (size_t)(row0 + lc) * 512 + h * 128 + 16 * w + 4 * q); }
        const float ig = valid ? ign : -1e30f, lf = valid ? lfn : 0.f;
        const float bcs = scan_add(lf), blast = rdlane(bcs, 63);
        const float av = ig - bcs;
        const float Mv = fmaxf(m, scan_max(av));
        const float iw = __expf(m - Mv), emt = __expf(-(bcs + Mv));
        const float gv = blast + av, mnew = fmaxf(blast + m, wave_max(gv));
        const float wprev = __expf(blast + m - mnew), wsv = __expf(gv - mnew);
        LDS_BARRIER();
#pragma unroll
        for (int c2 = 0; c2 < 2; ++c2) { const int ci = tid + 512 * c2, r = ci >> 4, c16 = ci & 15; const int lo = r * MLP + 8 * c16;
            *(LAS v4u*)(Qs + lo) = pq[c2]; *(LAS v4u*)(Ks + lo) = pk[c2]; *(LAS v4u*)(Vs + lo) = pv[c2];
            const float sc = bperm(wsv, r) * 0.08838834764831845f; v4u kw;
            kw.x = pk2(bflo(pk[c2].x) * sc, bfhi(pk[c2].x) * sc); kw.y = pk2(bflo(pk[c2].y) * sc, bfhi(pk[c2].y) * sc);
            kw.z = pk2(bflo(pk[c2].z) * sc, bfhi(pk[c2].z) * sc); kw.w = pk2(bflo(pk[c2].w) * sc, bfhi(pk[c2].w) * sc);
            *(LAS v4u*)(Kws + lo) = kw; }
        if (ch + 1 < nchunk) {
#pragma unroll
            for (int c2 = 0; c2 < 2; ++c2) { const int ci = tid + 512 * c2, r = ci >> 4, c16 = ci & 15; const size_t off = (size_t)(row0 + 64 + r) * 512 + h * 128 + 8 * c16;
                pq[c2] = *(const v4u*)(QA + off); pk[c2] = *(const v4u*)(KA + off); pv[c2] = *(const v4u*)(VA + off); }
            ign = GA[(size_t)(row0 + 64 + lcl) * 8 + h]; lfn = GA[(size_t)(row0 + 64 + lcl) * 8 + 4 + h]; }
        LDS_BARRIER();
        { const int st = w >> 1, lt0 = 2 * (w & 1);
          f32x4 sacc[2] = {{0.f, 0.f, 0.f, 0.f}, {0.f, 0.f, 0.f, 0.f}};
#pragma unroll
          for (int ks = 0; ks < 4; ++ks) { const bf16x8 a = *(const LAS bf16x8*)(Ks + (16 * st + li) * MLP + 32 * ks + 8 * q);
#pragma unroll
              for (int t2 = 0; t2 < 2; ++t2) { const bf16x8 bq = *(const LAS bf16x8*)(Qs + (16 * (lt0 + t2) + li) * MLP + 32 * ks + 8 * q); sacc[t2] = mfma16(a, bq, sacc[t2]); } }
          float a4[4];
#pragma unroll
          for (int r = 0; r < 4; ++r) a4[r] = bperm(av, 16 * st + 4 * q + r);
#pragma unroll
          for (int t2 = 0; t2 < 2; ++t2) { const int l = 16 * (lt0 + t2) + li; const float Ml = bperm(Mv, l); float vals[4], ps = 0.f;
#pragma unroll
              for (int r = 0; r < 4; ++r) { const int s = 16 * st + 4 * q + r; vals[r] = sacc[t2][r] * ((s <= l) ? 0.08838834764831845f : 0.f) * __expf(fminf(a4[r] - Ml, 0.f)); ps += vals[r]; }
              ps = qsum(ps);
              if (q == 0) SpS[st * 64 + l] = ps;
              u32x2 o; o.x = pk2(vals[0], vals[1]); o.y = pk2(vals[2], vals[3]);
              *(LAS u32x2*)(Ss + l * MSP + 16 * st + 4 * q) = o; }
          { const int l = tid >> 3, part = tid & 7; const LAS unsigned* qp = (const LAS unsigned*)(Qs + l * MLP + 16 * part); const LAS float* np = nS + 16 * part; float s = 0.f;
#pragma unroll
            for (int e = 0; e < 8; ++e) { const unsigned wq = qp[e]; s += bflo(wq) * np[2 * e] + bfhi(wq) * np[2 * e + 1]; }
            s = rsum8(s);
            if (part == 0) qnS[l] = s; } }
        LDS_BARRIER();
        bf16x8 vf[2];
        { f32x4 nacc[4];
#pragma unroll
          for (int lt = 0; lt < 4; ++lt) nacc[lt] = (f32x4){0.f, 0.f, 0.f, 0.f};
#pragma unroll
          for (int ks = 0; ks < 4; ++ks) { const bf16x8 a = *(const LAS bf16x8*)(CT + (16 * w + li) * MLP + 32 * ks + 8 * q);
#pragma unroll
              for (int lt = 0; lt < 4; ++lt) { const bf16x8 bq = *(const LAS bf16x8*)(Qs + (16 * lt + li) * MLP + 32 * ks + 8 * q); nacc[lt] = mfma16(a, bq, nacc[lt]); } }
#pragma unroll
          for (int lt = 0; lt < 4; ++lt) { const float iwl = bperm(iw, 16 * lt + li); nacc[lt] = nacc[lt] * iwl; }
#pragma unroll
          for (int k2 = 0; k2 < 2; ++k2) { const LAS unsigned short* vp = Vs + (32 * k2 + 8 * q + qq) * MLP + 16 * w + 4 * pp;
              vf[k2] = cat8(ldtr(vp), ldtr(vp + 4 * MLP));
#pragma unroll
              for (int lt = 0; lt < 4; ++lt) { const bf16x8 bs = *(const LAS bf16x8*)(Ss + (16 * lt + li) * MSP + 32 * k2 + 8 * q); nacc[lt] = mfma16(vf[k2], bs, nacc[lt]); } }
          const float den = iw * qnS[lane] + ((SpS[lane] + SpS[64 + lane]) + (SpS[128 + lane] + SpS[192 + lane]));
          const float rs = 1.0f / fmaxf(fabsf(den), emt);
#pragma unroll
          for (int lt = 0; lt < 4; ++lt) { const int l = 16 * lt + li; const float rsl = bperm(rs, l); nacc[lt] = nacc[lt] * rsl;
              float ss = (nacc[lt][0] * nacc[lt][0] + nacc[lt][1] * nacc[lt][1]) + (nacc[lt][2] * nacc[lt][2] + nacc[lt][3] * nacc[lt][3]);
              ss = qsum(ss);
              if (q == 0) ssS[w * 64 + l] = ss; }
          LDS_BARRIER();
          float tot = 0.f;
#pragma unroll
          for (int w2 = 0; w2 < 8; ++w2) tot += ssS[w2 * 64 + lane];
          const float rstd = 1.0f / sqrtf(tot * (1.0f / 128.0f) + EPS);
          const f32x4 gn = *(const f32x4*)(gnorm + 16 * w + 4 * q);
#pragma unroll
          for (int lt = 0; lt < 4; ++lt) { const int l = 16 * lt + li; const float rl = bperm(rstd, l);
              if (l < L) { const size_t row = (size_t)(row0 + l); const u32x2 ov = ovp[lt];
                  const float o0 = nacc[lt][0] * rl * gn[0] * fast_sigmoid(bflo(ov.x)), o1 = nacc[lt][1] * rl * gn[1] * fast_sigmoid(bfhi(ov.x));
                  const float o2 = nacc[lt][2] * rl * gn[2] * fast_sigmoid(bflo(ov.y)), o3 = nacc[lt][3] * rl * gn[3] * fast_sigmoid(bfhi(ov.y));
                  u32x2 o; o.x = pk2(o0, o1); o.y = pk2(o2, o3);
                  *(u32x2*)(MIX + row * 1024 + h * 128 + 16 * w + 4 * q) = o; } } }
        f32x4 nsum = {0.f, 0.f, 0.f, 0.f}; const bf16x8 ones8 = {0x3f80, 0x3f80, 0x3f80, 0x3f80, 0x3f80, 0x3f80, 0x3f80, 0x3f80};
#pragma unroll
        for (int i = 0; i < 8; ++i) accC[i] = accC[i] * wprev;
#pragma unroll
        for (int k2 = 0; k2 < 2; ++k2) {
#pragma unroll
            for (int i = 0; i < 8; ++i) { const LAS unsigned short* kp = Kws + (32 * k2 + 8 * q + qq) * MLP + 16 * i + 4 * pp;
                const bf16x8 a = cat8(ldtr(kp), ldtr(kp + 4 * MLP)); accC[i] = mfma16(a, vf[k2], accC[i]);
                if (i == w) nsum = mfma16(a, ones8, nsum); } }
#pragma unroll
        for (int i = 0; i < 8; ++i) { u32x2 o; o.x = pk2(accC[i][0], accC[i][1]); o.y = pk2(accC[i][2], accC[i][3]); *(LAS u32x2*)(CT + (16 * w + li) * MLP + 16 * i + 4 * q) = o; }
        if (li == 0) {
#pragma unroll
            for (int r = 0; r < 4; ++r) nS[16 * w + 4 * q + r] = wprev * nS[16 * w + 4 * q + r] + nsum[r]; }
        m = mnew;
    }
#pragma unroll
    for (int i = 0; i < 8; ++i)
#pragma unroll
        for (int r = 0; r < 4; ++r) Cout[(size_t)(16 * i + 4 * q + r) * 128 + 16 * w + li] = accC[i][r];
    LDS_BARRIER();
    if (tid < 128) nout[tid] = nS[tid];
    if (tid == 0) *mout = m;
}

constexpr int AT_P = 72;
template <int NKT, int MODE>
__device__ __forceinline__ void attn_block(f32x4 (&accO)[4], float& mrun, float& lrun, const LAS unsigned short* Kt, const LAS unsigned short* Vt, const bf16x8 (&qf)[2],
                                           int rel0, const LAS float* tbl, int nvalid, int li, int q) {
    const int qq = li >> 2, pp = li & 3;
    constexpr float SC = 0.125f * 1.4426950408889634f;
    const LAS unsigned short* kb = Kt + li * AT_P + 8 * q;
    const LAS unsigned short* vb = Vt + (4 * q + qq) * AT_P + 4 * pp;
    f32x4 s[NKT];
#pragma unroll
    for (int kt = 0; kt < NKT; ++kt) { s[kt] = (f32x4){0.f, 0.f, 0.f, 0.f};
#pragma unroll
        for (int ks = 0; ks < 2; ++ks) { const bf16x8 a = *(const LAS bf16x8*)(kb + 16 * kt * AT_P + 32 * ks); s[kt] = mfma16(a, qf[ks], s[kt]); } }
    float mx = -1e30f;
    if (MODE == 0) { const float b0 = tbl[0];
#pragma unroll
        for (int kt = 0; kt < NKT; ++kt)
#pragma unroll
            for (int r = 0; r < 4; ++r) { s[kt][r] = s[kt][r] * SC + b0; mx = fmaxf(mx, s[kt][r]); }
    } else if (MODE == 1) { const LAS float* tb = tbl + (rel0 + 4 * q + 128);
#pragma unroll
        for (int kt = 0; kt < NKT; ++kt)
#pragma unroll
            for (int r = 0; r < 4; ++r) { s[kt][r] = s[kt][r] * SC + tb[16 * kt + r]; mx = fmaxf(mx, s[kt][r]); }
    } else {
#pragma unroll
        for (int kt = 0; kt < NKT; ++kt)
#pragma unroll
            for (int r = 0; r < 4; ++r) { const int key = 16 * kt + 4 * q + r; int rel = rel0 + key; rel = rel < -128 ? -128 : (rel > 128 ? 128 : rel);
                float v = s[kt][r] * SC + tbl[rel + 128]; if (MODE == 3) v = key < nvalid ? v : -1e30f; s[kt][r] = v; mx = fmaxf(mx, v); }
    }
    mx = qmax(mx);
    if (__any(mx > mrun)) {
        const float mnew = fmaxf(mrun, mx), alpha = __builtin_amdgcn_exp2f(mrun - mnew); mrun = mnew; lrun *= alpha;
#pragma unroll
        for (int dt = 0; dt < 4; ++dt) accO[dt] = accO[dt] * alpha; }
    float ps = 0.f;
#pragma unroll
    for (int kt = 0; kt < NKT; ++kt)
#pragma unroll
        for (int r = 0; r < 4; ++r) { const float p = __builtin_amdgcn_exp2f(s[kt][r] - mrun); s[kt][r] = p; ps += p; }
    lrun += ps;
#pragma unroll
    for (int k2 = 0; k2 < NKT / 2; ++k2) {
        v4u pw; pw.x = pk2(s[2 * k2][0], s[2 * k2][1]); pw.y = pk2(s[2 * k2][2], s[2 * k2][3]); pw.z = pk2(s[2 * k2 + 1][0], s[2 * k2 + 1][1]); pw.w = pk2(s[2 * k2 + 1][2], s[2 * k2 + 1][3]);
        const bf16x8 pb = __builtin_bit_cast(bf16x8, pw);
#pragma unroll
        for (int dt = 0; dt < 4; ++dt) { const LAS unsigned short* vp = vb + 32 * k2 * AT_P + 16 * dt;
            const bf16x8 a = cat8(ldtr(vp), ldtr(vp + 16 * AT_P)); accO[dt] = mfma16(a, pb, accO[dt]); } }
}
__device__ __forceinline__ void attn_store(const f32x4 (&accO)[4], float lrun, unsigned short* dst  , int q) {
    lrun = qsum(lrun);
    const float inv = 1.0f / lrun;
#pragma unroll
    for (int dt = 0; dt < 4; ++dt) { u32x2 o; o.x = pk2(accO[dt][0] * inv, accO[dt][1] * inv); o.y = pk2(accO[dt][2] * inv, accO[dt][3] * inv); *(u32x2*)(dst + 16 * dt + 4 * q) = o; }
}
constexpr int AT_TBL = 120832, AT_BUF = 0;
__device__ __forceinline__ void band_prompt_unit(LAS unsigned char* lds, const unsigned short* QB, const unsigned short* KB, const unsigned short* VB, unsigned short* MIX, int b, int c, int hp, int tid) {
    const int lane = tid & 63, w = __builtin_amdgcn_readfirstlane(tid >> 6), li = lane & 15, q = lane >> 4, hl = w >> 2, head = 2 * hp + hl, qoff = 16 * (w & 3) + li;
    const LAS float* tbl = (const LAS float*)(lds + AT_TBL) + head * 264;
    constexpr int BUFE = 2 * 64 * AT_P;
    LAS unsigned short* Kbuf = (LAS unsigned short*)(lds + AT_BUF); LAS unsigned short* Vbuf = Kbuf + 2 * BUFE;
    const size_t qrow = (size_t)b * 2048 + c * 64 + qoff;
    bf16x8 qf[2];
#pragma unroll
    for (int ks = 0; ks < 2; ++ks) qf[ks] = *(const bf16x8*)(QB + qrow * 512 + head * 64 + 32 * ks + 8 * q);
    f32x4 accO[4];
#pragma unroll
    for (int dt = 0; dt < 4; ++dt) accO[dt] = (f32x4){0.f, 0.f, 0.f, 0.f};
    float mrun = -1e30f, lrun = 0.f;
    const int kc0 = c > 8 ? c - 8 : 0;
    v4u rkA[2], rvA[2], rkB[2], rvB[2];
    const int key0 = tid >> 4, c16 = tid & 15, lo0 = (c16 >> 3) * 64 * AT_P + key0 * AT_P + 8 * (c16 & 7);
    const unsigned short* kg = KB + ((size_t)b * 2048 + key0) * 512 + hp * 128 + 8 * c16; const unsigned short* vg = VB + ((size_t)b * 2048 + key0) * 512 + hp * 128 + 8 * c16;
#define AT_GLOAD(rk, rv, kc_) do { const int kcc = (kc_) <= c ? (kc_) : c; const size_t o_ = (size_t)kcc * 64 * 512; rk[0] = *(const v4u*)(kg + o_); rk[1] = *(const v4u*)(kg + o_ + 32 * 512); rv[0] = *(const v4u*)(vg + o_); rv[1] = *(const v4u*)(vg + o_ + 32 * 512); } while (0)
#define AT_LWRITE(rk, rv, buf_) do { const int l_ = (buf_) * BUFE + lo0; *(LAS v4u*)(Kbuf + l_) = rk[0]; *(LAS v4u*)(Kbuf + l_ + 32 * AT_P) = rk[1]; *(LAS v4u*)(Vbuf + l_) = rv[0]; *(LAS v4u*)(Vbuf + l_ + 32 * AT_P) = rv[1]; } while (0)
#define AT_ARGS(kc_, buf_) accO, mrun, lrun, Kbuf + (buf_) * BUFE + hl * 64 * AT_P, Vbuf + (buf_) * BUFE + hl * 64 * AT_P, qf, ((kc_) - c) * 64 - qoff, tbl, 64, li, q
#define AT_COMPUTE(kc_, buf_) do { if ((kc_) + 3 <= c) attn_block<4, 0>(AT_ARGS(kc_, buf_)); else if ((kc_) + 2 == c) attn_block<4, 2>(AT_ARGS(kc_, buf_)); else attn_block<4, 1>(AT_ARGS(kc_, buf_)); } while (0)
    AT_GLOAD(rkA, rvA, kc0); AT_GLOAD(rkB, rvB, kc0 + 1);
    LDS_BARRIER();
    AT_LWRITE(rkA, rvA, 0);
    LDS_BARRIER();
    for (int kc = kc0; kc <= c; kc += 2) {
        AT_GLOAD(rkA, rvA, kc + 2);
        AT_COMPUTE(kc, 0);
        AT_LWRITE(rkB, rvB, 1);
        LDS_BARRIER();
        if (kc + 1 <= c) {
            AT_GLOAD(rkB, rvB, kc + 3);
            AT_COMPUTE(kc + 1, 1);
            AT_LWRITE(rkA, rvA, 0);
            LDS_BARRIER(); }
    }
#undef AT_GLOAD
#undef AT_LWRITE
#undef AT_COMPUTE
#undef AT_ARGS
    attn_store(accO, lrun, MIX + qrow * 1024 + 512 + head * 64, q);
}
__device__ __forceinline__ void band_sample_unit(LAS unsigned char* lds, const unsigned short* QB, const unsigned short* KB, const unsigned short* VB, const float* ck, const float* cv, unsigned short* MIX, int b, int tid) {
    const int lane = tid & 63, w = __builtin_amdgcn_readfirstlane(tid >> 6), li = lane & 15, q = lane >> 4;
    const LAS float* tbl = (const LAS float*)(lds + AT_TBL) + w * 264;
    constexpr int HE = 32 * AT_P;
    LAS unsigned short* Kbuf = (LAS unsigned short*)(lds + AT_BUF); LAS unsigned short* Vbuf = Kbuf + 8 * HE;
    const size_t qrow = (size_t)MP + b * 16 + li;
    bf16x8 qf[2];
#pragma unroll
    for (int ks = 0; ks < 2; ++ks) qf[ks] = *(const bf16x8*)(QB + qrow * 512 + w * 64 + 32 * ks + 8 * q);
    f32x4 accO[4];
#pragma unroll
    for (int dt = 0; dt < 4; ++dt) accO[dt] = (f32x4){0.f, 0.f, 0.f, 0.f};
    float mrun = -1e30f, lrun = 0.f;
    f32x4 kx[8], vx[8];
#define ATS_GLOAD(kb_) do { _Pragma("unroll") for (int i = 0; i < 8; ++i) { const int fi = tid + 512 * i, key = fi >> 7, c4 = fi & 127; const size_t off = ((size_t)b * 512 + 32 * (kb_) + key) * 512 + 4 * c4; kx[i] = *(const f32x4*)(ck + off); vx[i] = *(const f32x4*)(cv + off); } } while (0)
    ATS_GLOAD(0);
    for (int kb = 0; kb < 16; ++kb) {
        LDS_BARRIER();
#pragma unroll
        for (int i = 0; i < 8; ++i) { const int fi = tid + 512 * i, key = fi >> 7, c4 = fi & 127; const int lo = (c4 >> 4) * HE + key * AT_P + 4 * (c4 & 15);
            u32x2 o; o.x = pk2(kx[i][0], kx[i][1]); o.y = pk2(kx[i][2], kx[i][3]); *(LAS u32x2*)(Kbuf + lo) = o;
            o.x = pk2(vx[i][0], vx[i][1]); o.y = pk2(vx[i][2], vx[i][3]); *(LAS u32x2*)(Vbuf + lo) = o; }
        if (kb + 1 < 16) ATS_GLOAD(kb + 1);
        LDS_BARRIER();
        if (kb <= 11) attn_block<2, 0>(accO, mrun, lrun, Kbuf + w * HE, Vbuf + w * HE, qf, 32 * kb - 512 - li, tbl, 32, li, q);
        else if (kb == 12) attn_block<2, 2>(accO, mrun, lrun, Kbuf + w * HE, Vbuf + w * HE, qf, 32 * kb - 512 - li, tbl, 32, li, q);
        else attn_block<2, 1>(accO, mrun, lrun, Kbuf + w * HE, Vbuf + w * HE, qf, 32 * kb - 512 - li, tbl, 32, li, q);
    }
#undef ATS_GLOAD
    {
        v4u k4[4], v4[4];
#pragma unroll
        for (int c2 = 0; c2 < 4; ++c2) { const int ci = tid + 512 * c2, key = ci >> 6, c16 = ci & 63; const int keyc = key < 16 ? key : 15; const size_t off = ((size_t)MP + b * 16 + keyc) * 512 + 8 * c16;
            k4[c2] = *(const v4u*)(KB + off); v4[c2] = *(const v4u*)(VB + off); }
        LDS_BARRIER();
#pragma unroll
        for (int c2 = 0; c2 < 4; ++c2) { const int ci = tid + 512 * c2, key = ci >> 6, c16 = ci & 63; const int lo = (c16 >> 3) * HE + key * AT_P + 8 * (c16 & 7);
            *(LAS v4u*)(Kbuf + lo) = k4[c2]; *(LAS v4u*)(Vbuf + lo) = v4[c2]; }
        LDS_BARRIER();
        attn_block<2, 3>(accO, mrun, lrun, Kbuf + w * HE, Vbuf + w * HE, qf, -li, tbl, 16, li, q);
    }
    attn_store(accO, lrun, MIX + qrow * 1024 + 512 + w * 64, q);
}

__device__ __forceinline__ void mixer_phase(const Ctx& A, LAS unsigned char* lds, int vcu, int G, int tid) {
    unsigned char* ws = A.ws; float* out = A.out;
    const unsigned short* U = (const unsigned short*)(ws + WS_BIG);
    const unsigned short *QA = U, *KA = U + U_ELEMS, *VA = U + 2 * U_ELEMS, *OA = U + 3 * U_ELEMS, *QB = U + 4 * U_ELEMS, *KB = U + 5 * U_ELEMS, *VB = U + 6 * U_ELEMS;
    unsigned short* MIX = (unsigned short*)(ws + WS_XN); const float* GA = (const float*)(ws + WS_GA);
    const int NSEQ = 32;
    if (vcu < NSEQ) {
        const int b = vcu >> 2, h = vcu & 3;
        for (int rep = 0; rep < NREP(61); ++rep)
        mlstm_seq(lds, QA, KA, VA, OA, GA, MIX, inptr(22) + h * 128, b * 2048, h, 32, 64, nullptr, nullptr, nullptr,
                  out + O_PAC + (size_t)(b * 4 + h) * 16384, out + O_PAN + (b * 4 + h) * 128, out + O_PAM + b * 4 + h, tid);
        return;
    }
    const int wk = vcu - NSEQ, NWK = G - NSEQ;
    { LAS float* tb = (LAS float*)(lds + AT_TBL); for (int i = tid; i < 8 * 257; i += 512) tb[(i / 257) * 264 + (i % 257)] = inptr(25)[i] * 1.4426950408889634f; }
    constexpr int N_BS = 32, N_MS = 128, N_BP = 1024;
    for (int rep = 0; rep < NREP(62); ++rep)
    for (int it = wk; it < N_BS + N_MS + N_BP; it += NWK) {
        asm volatile("" : "+v"(tid));
        if (it < N_BS) { band_sample_unit(lds, QB, KB, VB, inptr(5), inptr(6), MIX, it, tid); }
        else if (it < N_BS + N_MS) { const int u = it - N_BS, b = u >> 2, h = u & 3;
            mlstm_seq(lds, QA, KA, VA, OA, GA, MIX, inptr(22) + h * 128, MP + b * 16, h, 1, 16,
                      inptr(2) + (size_t)(b * 4 + h) * 16384, inptr(3) + (b * 4 + h) * 128, inptr(4) + b * 4 + h,
                      out + O_SAC + (size_t)(b * 4 + h) * 16384, out + O_SAN + (b * 4 + h) * 128, out + O_SAM + b * 4 + h, tid); }
        else { const int u = it - N_BS - N_MS, hp = u & 3, c = (u >> 2) & 31, b = u >> 7; band_prompt_unit(lds, QB, KB, VB, MIX, b, c, hp, tid); }
    }
    asm volatile("" : "+v"(tid));
    LDS_BARRIER();
#if FOLD & 1
    bias_wg((const unsigned short*)(ws + WS_WFIN) + (size_t)2 * FIN_ELEMS, (const float*)(ws + WS_ADA) + 6 * 1024, (float*)(ws + WS_BIAS), lds, wk, NWK, tid);
    LDS_BARRIER();
#endif
    { const int wv = __builtin_amdgcn_readfirstlane(tid >> 6); p0_weights(A, (LAS float*)(lds + wv * 16384), 3, wk * NWAVES + wv, NWK * NWAVES, tid & 63); }
}

constexpr int RG_XB = 0, RG_GB = 18432, RG_XCB = 35840, RG_XCF = 53248, RG_Y = 87040, RG_HIN = 104448, RG_P = 108544;
constexpr int RGP = 136, RGF = 132;
__device__ __forceinline__ void rglru_unit(const Ctx& A, LAS unsigned char* lds, bool sample, int b, int tt, int nb0, int nb1, int tid) {
    unsigned char* ws = A.ws; float* out = A.out;
    const unsigned short* GBg = (const unsigned short*)(ws + WS_BIG); const unsigned short* XBg = GBg + (size_t)MT * 1024;
    unsigned short* YC = (unsigned short*)(ws + WS_XN); unsigned short* YP = (unsigned short*)(ws + WS_BIG) + (size_t)2 * MT * 1024; const unsigned short* GW = (const unsigned short*)(ws + WS_WGATE);
    float* CA = (float*)(ws + WS_CARRY); float* CU = CA + 8 * 32 * 1024;
    const int lane = tid & 63, w = __builtin_amdgcn_readfirstlane(tid >> 6), li = lane & 15, q = lane >> 4;
    const int L = sample ? 16 : 64, MTL = sample ? 1 : 4, row0 = sample ? MP + 16 * b : b * 2048 + 64 * tt;
    LAS unsigned short* XBs = (LAS unsigned short*)(lds + RG_XB); LAS unsigned short* GBs = (LAS unsigned short*)(lds + RG_GB); LAS unsigned short* XCB = (LAS unsigned short*)(lds + RG_XCB);
    LAS float* XCF = (LAS float*)(lds + RG_XCF); LAS unsigned short* Ys = (LAS unsigned short*)(lds + RG_Y); LAS float* hin = (LAS float*)(lds + RG_HIN); LAS unsigned short* Ps = (LAS unsigned short*)(lds + RG_P);
    const float* cstate = inptr(7);
    v4u xr[3], gr[2]; bf16x8 wr_[4], wi_[4];
    const v4u z4 = {0u, 0u, 0u, 0u};
    const float* convw = inptr(28); const float* convb = inptr(29); const float* gateb = inptr(31); const float* lam = inptr(32);
    float pw0, pw1, pw2, pw3, pcb, pgr, pgi, plm;
    const int nxc = (L + 3) * 16, ngc = L * 16;
#define RG_PREFETCH(n_) do { const int ch0_ = 128 * (n_); \
        _Pragma("unroll") for (int i = 0; i < 3; ++i) { const int ci0 = tid + 512 * i, ci = ci0 < nxc ? ci0 : nxc - 1, r = ci >> 4, c16 = ci & 15, tr = r - 3; \
            const bool use = (tr >= 0) || (!sample && tt > 0); const int trc = use ? tr : 0; \
            const v4u ld = *(const v4u*)(XBg + (size_t)(row0 + trc) * 1024 + ch0_ + 8 * c16); xr[i] = use ? ld : z4; } \
        if (sample && tid < 48) { const int r = tid >> 4, c16 = tid & 15; const float* cp = cstate + ((size_t)b * 3 + r) * 1024 + ch0_ + 8 * c16; const f32x4 c0 = *(const f32x4*)cp, c1 = *(const f32x4*)(cp + 4); \
            xr[0].x = pk2(c0[0], c0[1]); xr[0].y = pk2(c0[2], c0[3]); xr[0].z = pk2(c1[0], c1[1]); xr[0].w = pk2(c1[2], c1[3]); } \
        { _Pragma("unroll") for (int i = 0; i < 2; ++i) { const int ci0 = tid + 512 * i, ci = ci0 < ngc ? ci0 : ngc - 1, r = ci >> 4, c16 = ci & 15; gr[i] = *(const v4u*)(GBg + (size_t)(row0 + r) * 1024 + ch0_ + 8 * c16); } } \
        { const int cc = ch0_ + (tid & 127), cg = ch0_ + 16 * w + li; pw0 = convw[cc]; pw1 = convw[1024 + cc]; pw2 = convw[2048 + cc]; pw3 = convw[3072 + cc]; pcb = convb[cc]; pgr = gateb[cg]; pgi = gateb[1024 + cg]; plm = lam[cg]; } } while (0)
    float hv2[2] = {0.f, 0.f};
    if (sample) { hv2[0] = inptr(8)[(size_t)b * 1024 + tid]; hv2[1] = inptr(8)[(size_t)b * 1024 + tid + 512]; }
#define RG_PREFETCH_W(n_) do { _Pragma("unroll") for (int ks = 0; ks < 4; ++ks) { wr_[ks] = *(const bf16x8*)(GW + ((unsigned)(n_) * 256u + 16u * w + li) * 128u + 32u * ks + 8u * q); wi_[ks] = *(const bf16x8*)(GW + ((unsigned)(n_) * 256u + 128u + 16u * w + li) * 128u + 32u * ks + 8u * q); } } while (0)
    RG_PREFETCH(nb0); RG_PREFETCH_W(nb0);
    LDS_BARRIER();
    hin[tid] = hv2[0]; hin[tid + 512] = hv2[1];
    for (int n = nb0; n < nb1; ++n) {
        const int ch0 = 128 * n;
#pragma unroll
        for (int i = 0; i < 3; ++i) { const int ci = tid + 512 * i, r = ci >> 4, c16 = ci & 15; if (ci < nxc) *(LAS v4u*)(XBs + r * RGP + 8 * c16) = xr[i]; }
#pragma unroll
        for (int i = 0; i < 2; ++i) { const int ci = tid + 512 * i, r = ci >> 4, c16 = ci & 15; if (ci < L * 16) *(LAS v4u*)(GBs + r * RGP + 8 * c16) = gr[i]; }
        const int chn = ch0 + 16 * w + li;
        const float gbr = pgr, gbi = pgi, lm = plm;
        const int chl = tid & 127, tg = tid >> 7;
        const float w0 = pw0, w1 = pw1, w2 = pw2, w3 = pw3, cb = pcb;
        if (n + 1 < nb1) RG_PREFETCH(n + 1);
        LDS_BARRIER();
        if (tg * 16 < L) {
            const LAS unsigned short* xb0 = XBs + tg * 16 * RGP + chl; LAS float* xf0 = XCF + tg * 16 * RGF + chl; LAS unsigned short* xc0 = XCB + tg * 16 * RGP + chl;
            float xv[19];
#pragma unroll
            for (int i = 0; i < 19; ++i) xv[i] = bf2f(xb0[i * RGP]);
#pragma unroll
            for (int i = 0; i < 16; ++i) { const float xc = cb + w0 * xv[i] + w1 * xv[i + 1] + w2 * xv[i + 2] + w3 * xv[i + 3];
                xf0[i * RGF] = xc; xc0[i * RGP] = (unsigned short)(pk2(xc, 0.f) & 0xffffu); } }
        LDS_BARRIER();
        const float sp8l = 8.0f * 1.4426950408889634f * (fmaxf(-lm, 0.f) + log1pf(expf(-fabsf(lm))));
        float aa[4][4], uu[4][4];
        const LAS unsigned short* xcb0 = XCB + li * RGP + 8 * q; const LAS float* xcf0 = XCF + 4 * q * RGF + 16 * w + li;
        const LAS unsigned short* gb0 = GBs + 4 * q * RGP + 16 * w + li; LAS unsigned short* y0 = Ys + 4 * q * RGP + 16 * w + li; LAS unsigned short* p0 = Ps + 4 * q * RGP + 16 * w + li;
#pragma unroll
        for (int mt = 0; mt < 4; ++mt) {
            if (mt < MTL) { f32x4 ar = {0.f, 0.f, 0.f, 0.f}, ai = {0.f, 0.f, 0.f, 0.f};
#pragma unroll
                for (int ks = 0; ks < 4; ++ks) { const bf16x8 a = *(const LAS bf16x8*)(xcb0 + 16 * mt * RGP + 32 * ks); ar = mfma16(a, wr_[ks], ar); ai = mfma16(a, wi_[ks], ai); }
#pragma unroll
                for (int r = 0; r < 4; ++r) { const float rr = fast_sigmoid(ar[r] + gbr), ii = fast_sigmoid(ai[r] + gbi);
                    const float av_ = __builtin_amdgcn_exp2f(-sp8l * rr);
                    const float em = fmaxf(1.0f - av_ * av_, 0.f);
                    aa[mt][r] = av_; uu[mt][r] = __builtin_amdgcn_sqrtf(em) * ii * xcf0[(16 * mt + r) * RGF]; }
            } else {
#pragma unroll
                for (int r = 0; r < 4; ++r) { aa[mt][r] = 1.f; uu[mt][r] = 0.f; } } }
        if (n + 1 < nb1) RG_PREFETCH_W(n + 1);
        float hcar = hin[chn], atot = 1.f;
#pragma unroll
        for (int mt = 0; mt < 4; ++mt) { float sa = 1.f, su = 0.f;
#pragma unroll
            for (int r = 0; r < 4; ++r) { su = aa[mt][r] * su + uu[mt][r]; sa *= aa[mt][r]; }
            float myin = 0.f, myp = 1.f;
#pragma unroll
            for (int q2 = 0; q2 < 4; ++q2) { const float a2 = bperm(sa, li + 16 * q2), u2 = bperm(su, li + 16 * q2); myin = (q2 == q) ? hcar : myin; myp = (q2 == q) ? atot : myp; hcar = a2 * hcar + u2; atot *= a2; }
            if (mt < MTL) { float hh = myin, pp = myp;
#pragma unroll
                for (int r = 0; r < 4; ++r) { hh = aa[mt][r] * hh + uu[mt][r]; pp *= aa[mt][r];
                    const float g = bf2f(gb0[(16 * mt + r) * RGP]);
                    const float ge = g * __builtin_amdgcn_rcpf(1.0f + __builtin_amdgcn_exp2f(g * (-2.3022082f + -0.10294324f * (g * g))));
                    const unsigned pk = pk2(ge * hh, ge * pp);
                    y0[(16 * mt + r) * RGP] = (unsigned short)(pk & 0xffffu); p0[(16 * mt + r) * RGP] = (unsigned short)(pk >> 16); } } }
        if (q == 0) { if (sample) out[O_SCH + (size_t)b * 1024 + chn] = hcar; else { CA[((size_t)b * 1024 + chn) * 32 + tt] = atot; CU[((size_t)b * 1024 + chn) * 32 + tt] = hcar; } }
        LDS_BARRIER();
        for (int ci = tid; ci < L * 16; ci += 512) { const int r = ci >> 4, c16 = ci & 15; *(v4u*)(YC + (size_t)(row0 + r) * 1024 + ch0 + 8 * c16) = *(const LAS v4u*)(Ys + r * RGP + 8 * c16);
            if (!sample) *(v4u*)(YP + (size_t)(row0 + r) * 1024 + ch0 + 8 * c16) = *(const LAS v4u*)(Ps + r * RGP + 8 * c16); }
    }
#undef RG_PREFETCH
#undef RG_PREFETCH_W
}

__device__ __forceinline__ void rglru_fix(const Ctx& A, LAS unsigned char* lds, int b, int tt, int tid) {
    unsigned char* ws = A.ws; float* out = A.out;
    unsigned short* YC = (unsigned short*)(ws + WS_XN); const unsigned short* YP = (const unsigned short*)(ws + WS_BIG) + (size_t)2 * MT * 1024;
    const float* CA = (const float*)(ws + WS_CARRY); const float* CU = CA + 8 * 32 * 1024;
    LAS float* hin = (LAS float*)(lds + RG_HIN);
    const int row0 = b * 2048 + 64 * tt;
    float hv2[2];
#pragma unroll
    for (int e = 0; e < 2; ++e) { const int chn = tid + 512 * e;
        f32x4 ca[8], cu[8]; const f32x4* cap = (const f32x4*)(CA + ((size_t)b * 1024 + chn) * 32); const f32x4* cup = (const f32x4*)(CU + ((size_t)b * 1024 + chn) * 32);
#pragma unroll
        for (int k = 0; k < 8; ++k) { ca[k] = cap[k]; cu[k] = cup[k]; }
        float hv = 0.f, hall = 0.f;
#pragma unroll
        for (int k = 0; k < 32; ++k) { hall = ca[k >> 2][k & 3] * hall + cu[k >> 2][k & 3]; hv = (k + 1 == tt) ? hall : hv; }
        hv2[e] = hv;
        if (tt == 31) out[O_PCH + (size_t)b * 1024 + chn] = hall; }
    LDS_BARRIER();
    hin[tid] = hv2[0]; hin[tid + 512] = hv2[1];
    LDS_BARRIER();
    if (tt > 0) {
#pragma unroll 1
        for (int half = 0; half < 2; ++half) {
            v4u y0r[8], ypr[8];
#pragma unroll
            for (int i = 0; i < 8; ++i) { const int ci = tid + 512 * (8 * half + i), r = ci >> 7, c8 = ci & 127; const size_t o = (size_t)(row0 + r) * 1024 + 8 * c8; y0r[i] = *(const v4u*)(YC + o); ypr[i] = *(const v4u*)(YP + o); }
#pragma unroll
            for (int i = 0; i < 8; ++i) { const int ci = tid + 512 * (8 * half + i), r = ci >> 7, c8 = ci & 127; const size_t o = (size_t)(row0 + r) * 1024 + 8 * c8;
                const f32x4 h0 = *(const LAS f32x4*)(hin + 8 * c8), h1 = *(const LAS f32x4*)(hin + 8 * c8 + 4);
                v4u w;
                w.x = pk2(bflo(y0r[i].x) + bflo(ypr[i].x) * h0[0], bfhi(y0r[i].x) + bfhi(ypr[i].x) * h0[1]); w.y = pk2(bflo(y0r[i].y) + bflo(ypr[i].y) * h0[2], bfhi(y0r[i].y) + bfhi(ypr[i].y) * h0[3]);
                w.z = pk2(bflo(y0r[i].z) + bflo(ypr[i].z) * h1[0], bfhi(y0r[i].z) + bfhi(ypr[i].z) * h1[1]); w.w = pk2(bflo(y0r[i].w) + bflo(ypr[i].w) * h1[2], bfhi(y0r[i].w) + bfhi(ypr[i].w) * h1[3]);
                *(v4u*)(YC + o) = w; } } }
}

__device__ __forceinline__ int mytid_fn(int wave_s) { unsigned ones = ~0u; asm volatile("" : "+s"(ones));
    return wave_s * 64 + (int)__builtin_amdgcn_mbcnt_hi(ones, __builtin_amdgcn_mbcnt_lo(ones, 0u)); }
#ifndef DUP_P0
#define DUP_P0 0
#endif

#ifdef NO_GEMM
#define GEMM_CALL if (false)
#else
#define GEMM_CALL
#endif
__global__ void __launch_bounds__(NWAVES * 64, 2) fwd_megakernel(Args args) {
    extern __shared__ __attribute__((aligned(16))) unsigned char lds_raw[];
    LAS unsigned char* lds = (LAS unsigned char*)lds_raw;
    volatile LAS unsigned* MISC = (volatile LAS unsigned*)(lds + MISC_OFF);
    const int wave_s = __builtin_amdgcn_readfirstlane((int)threadIdx.x >> 6);
#define MYTID() mytid_fn(wave_s)
    int tid = MYTID(), G = gridDim.x, bx = blockIdx.x;
    unsigned char* ws = args.ws; float* out = args.out;
#define lane (tid & 63)
#define wave (__builtin_amdgcn_readfirstlane(tid >> 6))
#define vcu ((G % 8 == 0) ? (bx % 8) * (G / 8) + bx / 8 : bx)
#define gw (vcu * NWAVES + wave)
#define NGW (G * NWAVES)
    gu32* ctl = (gu32*)(ws + WS_CTL);
    for (int u = tid; u < (LDS_BYTES - LDSCTL_OFF) / 4; u += NWAVES * 64) ((LAS unsigned*)(lds + LDSCTL_OFF))[u] = 0u;
    __syncthreads();
    XcdBarrier bar = xcd_barrier_post((unsigned*)(ctl + CW_BAR), MISC + 8);
#define GRID_BAR() do { xcd_barrier(bar, MYTID() == 0); tid = MYTID(); G = gridDim.x; bx = blockIdx.x; asm volatile("" : "+v"(tid)); asm volatile("" : "+s"(G), "+s"(bx)); } while (0)
#define ADAP ((float*)(ws + WS_ADAP))
#define ADA ((float*)(ws + WS_ADA))
#define XN ((unsigned short*)(ws + WS_XN))
#define BIG ((unsigned short*)(ws + WS_BIG))
#define XR ((unsigned short*)(ws + WS_XR))

    for (int rep = 0; rep < ((DUP_P0) ? 2 : 1); ++rep)
    {
#ifndef NO_ADA
      for (int wgi = vcu; wgi < 256; wgi += G) p0_ada_mfma(inptr(9), inptr(10), inptr(18), ADAP, lds, wgi, tid);
#endif
      __syncthreads();
#ifndef NO_P0W
      p0_weights(Ctx{out, ws}, (LAS float*)(lds + wave * 16384), 0, gw, NGW, lane);
#endif
    GRID_BAR(); }

    for (int l = 0; l < 2; ++l) {
        for (int s = 0; s < 3; ++s) {
            const bool first = (l == 0 && s == 0);
            const int fidx = s == 1 ? 3 : (s == 2 ? 2 * l : 1); const bool fold = !first && (s != 1 || l == 1) && ((FOLD >> fidx) & 1);
            const int sp_ = s == 0 ? 2 : s - 1, lp_ = s == 0 ? l - 1 : l;
            const bool xs_big = fold && sp_ == 1 && s != 1;
            unsigned short* const XSb = (s == 1) ? (unsigned short*)(ws + WS_XS3) : (xs_big ? BIG : XN);
            if (!fold)
            for (int rep = 0; rep < NREP(2); ++rep) {
                const float* adaL = ADA + (size_t)l * NBR * NADA;
                const float* nw = inptr(s == 0 ? 11 : (s == 1 ? 14 : 15)) + (size_t)l * D;
                const int sp = s == 0 ? 2 : s - 1, lp = s == 0 ? l - 1 : l;
                const float* fx_slab = (const float*)(ws + WS_SLAB); const int fx_npart = first ? 0 : (sp == 1 ? 8 : 11); const bool fx_bf32 = (l == 0 && s == 1);
                const float* fx_gate = ADA + (size_t)(lp < 0 ? 0 : lp) * NBR * NADA + (3 * sp + 2) * 1024; const float fx_s = sp == 1 ? 1.0f : 0.5f;
                if (l == 0 && s == 1) norm_phase<true>(inptr(0), inptr(1), XR, first, nw, adaL, 3 * s, XN, inptr(20), inptr(21), (float*)(ws + WS_GA), (LAS float*)lds, fx_slab, fx_npart, fx_bf32, fx_gate, fx_s, (rep + 1 < NREP(2)), first ? ADAP : nullptr, inptr(19), ADA, gw, NGW, lane, tid);
                else norm_phase<false>(inptr(0), inptr(1), XR, first, nw, adaL, 3 * s, XN, nullptr, nullptr, nullptr, (LAS float*)lds, fx_slab, fx_npart, fx_bf32, fx_gate, fx_s, (rep + 1 < NREP(2)), first ? ADAP : nullptr, inptr(19), ADA, gw, NGW, lane, tid);
                GRID_BAR();
            }
            int rsel;
            if (s != 1) {
                const int f = (s == 0 ? 0 : 2) + l;
                unsigned short* const Hb = xs_big ? (unsigned short*)(ws + WS_H2) : BIG;
                for (int rep = 0; rep < NREP(3); ++rep) {
                  const int nlight = G - (66 * 22) % G, li0 = bx - (66 * 22) % G;
                  unsigned* sctr = (unsigned*)(ctl + (CTL_SCTR + 256 * fidx) / 4);
                  if (fold && rep == 0 && li0 >= 0 && nlight < G) {
                      const float* adaL = ADA + (size_t)l * NBR * NADA;
                      sample_fold(XR, (const float*)(ws + WS_SLAB), sp_ == 1 ? 8 : 11, ADA + (size_t)lp_ * NBR * NADA + (3 * sp_ + 2) * 1024, sp_ == 1 ? 1.0f : 0.5f,
                                  inptr(s == 0 ? 11 : 15) + (size_t)l * D, adaL, 3 * s, XSb, (LAS float*)lds, sctr, li0, nlight, tid); }
                  pg8::Gemm g{fold ? XSb : XN, (const unsigned short*)(ws + WS_WFIN) + (size_t)f * FIN_ELEMS, MT, 2 * DFF, D};
                  if (fold) { pg8::GatedOrder S; S.init(MT, 2 * DFF, G, bx, D); S.ctr = sctr; S.need = (unsigned)nlight; S.seen = 0;
                      pg8::EpiSwigluT<true> E{Hb, DFF, (const unsigned long long*)(ws + CTL_SSQ) + (size_t)fidx * MP, (const float*)(ws + WS_BIAS) + (size_t)fidx * NBR * 5632, (LAS float*)(lds + LDSCTL_OFF + 1024)};
                      GEMM_CALL pg8::gemm_phase<pg8::EpiSwigluT<true>, pg8::GatedOrder, true, true>(lds, g, S, E, tid); }
                  else { pg8::StaticOrder S; S.init(MT, 2 * DFF, G, bx, D);
                      pg8::EpiSwiglu E{Hb, DFF, nullptr, nullptr, nullptr};
                      GEMM_CALL pg8::gemm_phase<pg8::EpiSwiglu, pg8::StaticOrder, true, true>(lds, g, S, E, tid); }
                  if (first) {
                      if (li0 >= 0 && nlight < G) p0_weights(Ctx{out, ws}, (LAS float*)(lds + wave * 16384), 1, li0 * NWAVES + wave, nlight * NWAVES, lane); }
                  if (((l == 0 && s == 2 && (FOLD & 10)) || (l == 1 && s == 0 && (FOLD & 4))) && li0 >= 0 && nlight < G) {
                      tid = MYTID(); asm volatile("" : "+v"(tid));
                      const int fn = s == 2 ? 1 : 3, jn = s == 2 ? 0 : 6, fi = s == 2 ? 1 : 2;
                      bias_wg((const unsigned short*)(ws + WS_WFIN) + (size_t)fn * FIN_ELEMS, ADA + (size_t)NBR * NADA + jn * 1024, (float*)(ws + WS_BIAS) + (size_t)fi * NBR * 5632, lds, li0, nlight, tid);
                      if (s == 2 && (FOLD & 8)) bias_wg((const unsigned short*)(ws + WS_WCIN), ADA + (size_t)NBR * NADA + 3 * 1024, (float*)(ws + WS_BIASC), lds, li0, nlight, tid, 64, 2048); }
                  GRID_BAR(); }
                rsel = 0;
            } else if (l == 0) {
                for (int rep = 0; rep < ((DUP == 5 || DUP == 51) ? 2 : 1); ++rep) {
                  pg8::Gemm g{XN, (const unsigned short*)(ws + WS_WABIN), MT, 3584, D}; pg8::StaticOrder S; S.init(MT, 3584, G, bx, D);
                  pg8::EpiABin E{BIG, U_ELEMS, inptr(23), inptr(24), out + O_PBK, out + O_PBV, out + O_SBK, out + O_SBV, EPS, (DUP == 51 && rep == 0) ? 1 : 0};
                  GEMM_CALL pg8::gemm_phase<pg8::EpiABin, pg8::StaticOrder, true, true>(lds, g, S, E, tid);
                  { const int nlight = G - (66 * 14) % G, li0 = bx - (66 * 14) % G;
                      if (li0 >= 0 && nlight < G) p0_weights(Ctx{out, ws}, (LAS float*)(lds + wave * 16384), 2, li0 * NWAVES + wave, nlight * NWAVES, lane); }
                  GRID_BAR(); }
                for (int rep = 0; rep < NREP(6); ++rep) {
#ifndef NO_MIXER
                  mixer_phase(Ctx{out, ws}, lds, bx, G, tid);
#endif
                  GRID_BAR(); }
                rsel = 1;
            } else {
                for (int rep = 0; rep < NREP(7); ++rep) {
                  pg8::Gemm g{fold ? XSb : XN, (const unsigned short*)(ws + WS_WCIN), MT, 2048, D};
                  if (fold) {
                      const int nheavy = (66 * 8) % G, li0 = bx - nheavy, nlight = G - nheavy;
                      unsigned* sctr = (unsigned*)(ctl + (CTL_SCTR + 256 * fidx) / 4);
                      if (rep == 0 && li0 >= 0 && nlight < G) { const float* adaL = ADA + (size_t)l * NBR * NADA;
                          sample_fold(XR, (const float*)(ws + WS_SLAB), 11, ADA + (size_t)lp_ * NBR * NADA + (3 * sp_ + 2) * 1024, 0.5f, inptr(14) + (size_t)l * D, adaL, 3 * s, XSb, (LAS float*)lds, sctr, li0, nlight, tid); }
                      pg8::GatedOrder S; S.init(MT, 2048, G, bx, D); S.ctr = sctr; S.need = (unsigned)nlight; S.seen = 0;
                      pg8::EpiCinT<true> E{BIG, BIG + (size_t)MT * 1024, out + O_PCC, out + O_SCC, (const unsigned long long*)(ws + CTL_SSQ) + (size_t)fidx * MP, (const float*)(ws + WS_BIASC), (LAS float*)(lds + LDSCTL_OFF + 1024)};
                      GEMM_CALL pg8::gemm_phase<pg8::EpiCinT<true>, pg8::GatedOrder, true, true>(lds, g, S, E, tid); }
                  else { pg8::StaticOrder S; S.init(MT, 2048, G, bx, D);
                      pg8::EpiCin E{BIG, BIG + (size_t)MT * 1024, out + O_PCC, out + O_SCC, nullptr, nullptr, nullptr};
                      GEMM_CALL pg8::gemm_phase<pg8::EpiCin, pg8::StaticOrder, true, true>(lds, g, S, E, tid); }
                  GRID_BAR(); }
                for (int rep = 0; rep < NREP(8); ++rep) {
                  for (int u = vcu; u < 512; u += G) { if (u < 256) rglru_unit(Ctx{out, ws}, lds, false, u >> 5, u & 31, 0, 8, tid);
                      else { const int j = u - 256; rglru_unit(Ctx{out, ws}, lds, true, j >> 3, 0, j & 7, (j & 7) + 1, tid); } }
                  GRID_BAR();
                  for (int u = vcu; u < 256; u += G) rglru_fix(Ctx{out, ws}, lds, u >> 5, u & 31, tid);
                  GRID_BAR(); }
                rsel = 2;
            }
#if DUP == 9
            GRID_BAR();
#endif
            for (int rep = 0; rep < NREP(4); ++rep) { const bool lastr = (l == 1 && s == 2);
              const float* adaL = ADA + (size_t)l * NBR * NADA;
              const int f = (s == 0 ? 0 : 2) + l;
              const unsigned short* rA = rsel == 0 ? (xs_big ? (const unsigned short*)(ws + WS_H2) : BIG) : XN;
              const int sn = s == 2 ? 0 : s + 1, ln = s == 2 ? l + 1 : l, fnx = sn == 1 ? 3 : (sn == 2 ? 2 * ln : 1);
              const bool foldn = ln < 2 && (sn != 1 || ln == 1) && ((FOLD_RES >> fnx) & 1);
              const unsigned short* rB = rsel == 0 ? (const unsigned short*)(ws + WS_WFOUT) + (size_t)f * FOUT_ELEMS : (const unsigned short*)(ws + (rsel == 1 ? WS_WABOUT : WS_WCOUT));
              pg8::Gemm g{rA, rB, MT, D, rsel == 0 ? DFF : D}; pg8::ResOrder S; S.init(G, bx, rsel == 0 ? DFF : D, rsel == 0 ? 4 : 2);
              pg8::EpiRes E{inptr(0), inptr(1), XR, out, adaL + (3 * s + 2) * 1024, rsel == 0 ? 0.5f : 1.0f, (float*)(ws + WS_SLAB), first ? 1 : 0, lastr ? 1 : 0, (rep + 1 < NREP(4)) ? (unsigned short*)(ws + WS_END) : nullptr,
                            foldn ? (sn == 1 ? (unsigned short*)(ws + WS_XS3) : (rsel == 0 ? XN : BIG)) : nullptr, inptr(sn == 0 ? 11 : (sn == 1 ? 14 : 15)) + (size_t)(ln & 1) * D, ADA + (size_t)(ln & 1) * NBR * NADA + (3 * sn + 1) * 1024, (unsigned long long*)(ws + CTL_SSQ) + (size_t)fnx * MP,
                            (foldn && ln < 2 && ((FOLD >> fnx) & 1)) ? 1 : 0, fold ? XSb : nullptr, inptr(s == 0 ? 11 : (s == 1 ? 14 : 15)) + (size_t)l * D, adaL + (3 * s + 1) * 1024};
              GEMM_CALL pg8::gemm_phase<pg8::EpiRes, pg8::ResOrder, true, true>(lds, g, S, E, tid);
              GRID_BAR(); }
        }
    }
    { f32x4 v[4]; for (int row = MP + gw; row < MT; row += NGW) fix_row(v, row, nullptr, XR, (const float*)(ws + WS_SLAB), 11, false, ADA + (size_t)NBR * NADA + 8 * 1024, 0.5f, out, lane); }
}

extern "C" void kernel_launch(void* const* d_in, const int* in_sizes, int n_in, void* d_out, int out_size, void* d_ws, size_t ws_size, hipStream_t stream) {
    static int grid = 0;
    if (grid == 0) {
        if (n_in != 34 || (size_t)out_size != O_TOTAL || ws_size < WS_END) { fprintf(stderr, "kernel_launch: unexpected problem: n_in %d out %d ws %zu\n", n_in, out_size, ws_size); grid = -1; return; }
        int dev = 0, cus = 0, per_cu = 0;
        if (hipGetDevice(&dev) != hipSuccess || hipDeviceGetAttribute(&cus, hipDeviceAttributeMultiprocessorCount, dev) != hipSuccess) { grid = -1; return; }
        if (hipFuncSetAttribute((const void*)fwd_megakernel, hipFuncAttributeMaxDynamicSharedMemorySize, LDS_BYTES) != hipSuccess) { fprintf(stderr, "kernel_launch: hipFuncSetAttribute failed\n"); grid = -1; return; }
        if (hipOccupancyMaxActiveBlocksPerMultiprocessor(&per_cu, (const void*)fwd_megakernel, NWAVES * 64, LDS_BYTES) != hipSuccess || per_cu < 1) fprintf(stderr, "kernel_launch: occupancy query says %d\n", per_cu);
        (void)hipGetLastError();
        grid = cus;
    }
    if (grid < 0) return;
    (void)hipMemsetAsync((char*)d_ws + WS_CTL, 0, CTL_ZERO_BYTES, stream);
    Args a{};
    for (int i = 0; i < 34; ++i) a.in[i] = (const float*)d_in[i];
    a.out = (float*)d_out; a.ws = (unsigned char*)d_ws;
    hipLaunchKernelGGL(fwd_megakernel, dim3(grid), dim3(NWAVES * 64), LDS_BYTES, stream, a);
}
```

```cpp
#include <hip/hip_runtime.h>
#include <cstdio>
#include <cstdint>
namespace pg8 {
#define PG8_LAS __attribute__((address_space(3)))
typedef unsigned short bf16_t;
typedef short bf16x8 __attribute__((ext_vector_type(8)));
typedef float f32x4 __attribute__((ext_vector_type(4)));
typedef unsigned u32x4 __attribute__((ext_vector_type(4)));
constexpr int BM = 256, BK = 64, HALF = 128, HTB = HALF * BK * 2  , STAGE_BYTES = 8 * HTB, NXCD = 8, WGM = 2;

__host__ __device__ __forceinline__ int lds_byte(int r, int c) { const int st = (r >> 4) * 2 + (c >> 5), rr = r & 15, cc = c & 31, ob = rr * 64 + cc * 2; return st * 1024 + (ob ^ (((ob >> 9) & 1) << 5)); }
__host__ __device__ __forceinline__ void stage_rc(int b, int& R, int& C) { const int st = b / 1024, sb = b % 1024, swz = sb ^ (((sb >> 9) & 1) << 5); R = (st >> 1) * 16 + swz / 64; C = (st & 1) * 32 + (swz % 64) / 2; }
__host__ __device__ __forceinline__ int perm32(int rho) { const int n = rho >> 4, i = rho & 15; return 8 * (i >> 2) + 4 * n + (i & 3); }

struct Unit { int pm, pn, part; };
struct Gemm { const bf16_t* A; const bf16_t* Bt; int M, N, K; };

struct StaticOrder {
    int nM, nN, nwg, G, c, ntf;
    __host__ __device__ void init(int M, int N, int G_, int c_, int K_ = 0) { nM = M / BM; nN = N / BM; nwg = nM * nN; G = G_; c = c_; ntf = K_ / BK; }
    __host__ __device__ bool next(int i, Unit& u) const {
        const long L = (long)i * G + c; if (L >= nwg) return false;
        int wgid = (int)L; { const int q = nwg / NXCD, r = nwg % NXCD, xcd = wgid % NXCD, off = wgid / NXCD; wgid = (xcd < r ? xcd * (q + 1) : r * (q + 1) + (xcd - r) * q) + off; }
        const int nig = WGM * nN, gid = wgid / nig, fm = gid * WGM, gsz = (nM - fm) < WGM ? (nM - fm) : WGM;
        u.pm = fm + ((wgid % nig) % gsz); u.pn = (wgid % nig) / gsz; if (gid & 1) u.pn = nN - 1 - u.pn; u.part = -1; return true;
    }
    __host__ __device__ int k0(const Unit&) const { return 0; }
    __host__ __device__ int nt(const Unit&) const { return ntf; }
    __device__ __forceinline__ void a_ready(const Unit&, int) const {}
    __device__ __forceinline__ void done(const Unit&) const {}
};
struct GatedOrder : StaticOrder {
    const unsigned* ctr; unsigned need; mutable int seen;
    __device__ __forceinline__ void a_ready(const Unit& u, int wid) const {
        if (u.pm < 64 || seen) return;
        seen = 1;
        if (wid == 0) { unsigned sp = 0;
            while ((unsigned)__builtin_amdgcn_readfirstlane(__hip_atomic_load(ctr, __ATOMIC_RELAXED, __HIP_MEMORY_SCOPE_AGENT)) < need) { __builtin_amdgcn_s_sleep(2); if (++sp > (1u << 20)) break; }
            __builtin_amdgcn_fence(__ATOMIC_ACQUIRE, "agent");
            asm volatile("s_waitcnt vmcnt(0)" ::: "memory"); }
        asm volatile("" ::: "memory"); __builtin_amdgcn_s_barrier(); asm volatile("" ::: "memory");
    }
};
struct ResOrder {
    StaticOrder so; int nch, CH;
    __host__ __device__ void init(int G_, int c_, int K_, int CH_) { so.init(16384, 1024, G_, c_, K_); CH = CH_; nch = (K_ / BK) / CH_; }
    __host__ __device__ bool next(int i, Unit& u) const {
        if (so.next(i, u)) return true;
        const int imain = so.c < so.nwg ? (so.nwg - so.c + so.G - 1) / so.G : 0;
        const int j = (i - imain) * so.G + so.c; if (j >= 8 * nch) return false;
        u.pm = 64 + ((j & 7) >> 2); u.pn = j & 3; u.part = j >> 3; return true;
    }
    __host__ __device__ int k0(const Unit& u) const { return u.part < 0 ? 0 : u.part * CH; }
    __host__ __device__ int nt(const Unit& u) const { return u.part < 0 ? so.ntf : CH; }
    __device__ __forceinline__ void a_ready(const Unit&, int) const {}
    __device__ __forceinline__ void done(const Unit&) const {}
};
__device__ __forceinline__ unsigned cvt_pk_bf16(float lo, float hi) { unsigned r; asm volatile("v_cvt_pk_bf16_f32 %0, %1, %2" : "=v"(r) : "v"(lo), "v"(hi)); return r; }
typedef float f32x2 __attribute__((ext_vector_type(2)));
constexpr int MPROWS = 16384;
__device__ __forceinline__ int bidx(int row) { return row < MPROWS ? (row >> 11) : 8 + ((row - MPROWS) >> 4); }
typedef __bf16 bf16x2_t __attribute__((ext_vector_type(2)));
__device__ __forceinline__ unsigned pk2(float lo, float hi) { f32x2 v = {lo, hi}; bf16x2_t b = __builtin_convertvector(v, bf16x2_t); return __builtin_bit_cast(unsigned, b); }
__device__ __forceinline__ float fast_sigmoid(float x) { return __builtin_amdgcn_rcpf(1.0f + __builtin_amdgcn_exp2f(-1.44269504f * x)); }

template <int CTRL, int ROW_MASK = 0xf, int BANK_MASK = 0xf>
__device__ __forceinline__ float dppf(float old, float src) { return __int_as_float(__builtin_amdgcn_update_dpp(__float_as_int(old), __float_as_int(src), CTRL, ROW_MASK, BANK_MASK, false)); }
__device__ __forceinline__ float swz16(float v) { return __int_as_float(__builtin_amdgcn_ds_swizzle(__float_as_int(v), 0x401F)); }
__device__ __forceinline__ float bperm(float v, int srclane) { return __int_as_float(__builtin_amdgcn_ds_bpermute(srclane << 2, __float_as_int(v))); }
__device__ __forceinline__ float rdlane(float v, int l) { return __int_as_float(__builtin_amdgcn_readlane(__float_as_int(v), l)); }
__device__ __forceinline__ float qsum(float v) { v += swz16(v); const auto r = __builtin_amdgcn_permlane32_swap(__float_as_uint(v), __float_as_uint(v), false, false); return __uint_as_float(r[0]) + __uint_as_float(r[1]); }
__device__ __forceinline__ float qmax(float v) { v = fmaxf(v, swz16(v)); const auto r = __builtin_amdgcn_permlane32_swap(__float_as_uint(v), __float_as_uint(v), false, false); return fmaxf(__uint_as_float(r[0]), __uint_as_float(r[1])); }
__device__ __forceinline__ float rsum16(float v) { v += dppf<0xB1>(v, v); v += dppf<0x4E>(v, v); v += dppf<0x141>(v, v); v += dppf<0x140>(v, v); return v; }
__device__ __forceinline__ float rmax16(float v) { v = fmaxf(v, dppf<0xB1>(v, v)); v = fmaxf(v, dppf<0x4E>(v, v)); v = fmaxf(v, dppf<0x141>(v, v)); v = fmaxf(v, dppf<0x140>(v, v)); return v; }
__device__ __forceinline__ float rsum8(float v) { v += dppf<0xB1>(v, v); v += dppf<0x4E>(v, v); v += dppf<0x141>(v, v); return v; }
__device__ __forceinline__ float wave_sum(float v) { return qsum(rsum16(v)); }
__device__ __forceinline__ float wave_max(float v) { return qmax(rmax16(v)); }
__device__ __forceinline__ float scan_add(float v) {
    v += dppf<0x111>(0.f, v); v += dppf<0x112>(0.f, v); v += dppf<0x114>(0.f, v); v += dppf<0x118>(0.f, v);
    v += dppf<0x142, 0xa>(0.f, v); v += dppf<0x143, 0xc>(0.f, v); return v; }
__device__ __forceinline__ float scan_max(float v) { const float ni = -3.0e38f;
    v = fmaxf(v, dppf<0x111>(ni, v)); v = fmaxf(v, dppf<0x112>(ni, v)); v = fmaxf(v, dppf<0x114>(ni, v)); v = fmaxf(v, dppf<0x118>(ni, v));
    v = fmaxf(v, dppf<0x142, 0xa>(ni, v)); v = fmaxf(v, dppf<0x143, 0xc>(ni, v)); return v; }

template <bool FOLDED>
struct EpiSwigluT {
    static constexpr bool PERM = true, AFTER_DRAIN = false;
    static constexpr bool HAS_PRE = FOLDED; struct Pre { unsigned long long q; float b; };
    bf16_t* H; int ldh;
    const unsigned long long* ssq; const float* bias; PG8_LAS float* tab;
    __device__ __forceinline__ Pre pre_load(const Unit& u, int tid) const {
        Pre p{0ull, 0.f};
        if (ssq) { const int pm = u.pm < 64 ? u.pm : 63, i = tid & 255; p.q = ssq[pm * BM + i]; p.b = bias[(size_t)(pm >> 3) * 5632 + u.pn * BM + i]; }
        return p; }
    __device__ __forceinline__ void pre_store(const Pre& p, int tid) const {
        if (ssq) { if (tid < 256) tab[tid] = __builtin_amdgcn_rsqf((float)p.q * (1.0f / (268435456.0f * 1024.0f)) + 1e-6f); else tab[tid] = p.b; } }
    __device__ __forceinline__ void operator()(const f32x4 (&acc)[2][2][4][2], const Unit& u, int wr, int wc, int fr, int fq) const {
        const int row0 = u.pm * BM + wr * 64 + fr, col0 = u.pn * HALF + wc * 32 + 8 * fq;
        float rs[2][4]; f32x4 bg[2], bu[2];
#pragma unroll
        for (int ai = 0; ai < 2; ++ai)
#pragma unroll
            for (int m = 0; m < 4; ++m) rs[ai][m] = 1.0f;
        bg[0] = bg[1] = bu[0] = bu[1] = (f32x4){0.f, 0.f, 0.f, 0.f};
        if (FOLDED && u.pm < 64) {
#pragma unroll
            for (int ai = 0; ai < 2; ++ai)
#pragma unroll
                for (int m = 0; m < 4; ++m) rs[ai][m] = tab[ai * HALF + wr * 64 + m * 16 + fr];
            const PG8_LAS float* bp = tab + 256 + wc * 32 + 8 * fq;
            bg[0] = *(const PG8_LAS f32x4*)bp; bg[1] = *(const PG8_LAS f32x4*)(bp + 4); bu[0] = *(const PG8_LAS f32x4*)(bp + HALF); bu[1] = *(const PG8_LAS f32x4*)(bp + HALF + 4); }
#pragma unroll
        for (int ai = 0; ai < 2; ++ai)
#pragma unroll
            for (int m = 0; m < 4; ++m) { bf16_t* rowp = H + (size_t)(row0 + ai * HALF + m * 16) * ldh + col0;
                float h[8];
#pragma unroll
                for (int n = 0; n < 2; ++n)
#pragma unroll
                    for (int j = 0; j < 4; ++j) { const float g = FOLDED ? acc[ai][0][m][n][j] * rs[ai][m] + bg[n][j] : acc[ai][0][m][n][j], up = FOLDED ? acc[ai][1][m][n][j] * rs[ai][m] + bu[n][j] : acc[ai][1][m][n][j]; h[4 * n + j] = (g * up) * __builtin_amdgcn_rcpf(1.0f + __builtin_amdgcn_exp2f(g)); }
                u32x4 w; w.x = pk2(h[0], h[1]); w.y = pk2(h[2], h[3]); w.z = pk2(h[4], h[5]); w.w = pk2(h[6], h[7]);
                *(u32x4*)rowp = w; }
    }
};

typedef EpiSwigluT<false> EpiSwiglu;

struct EpiRes {
    static constexpr bool PERM = true, AFTER_DRAIN = false;
    static constexpr bool HAS_PRE = false; struct Pre {};
    const float* base_p; const float* base_s; bf16_t* xh; float* outf; const float* gate; float s; float* slab; int first, last; bf16_t* dummy;
    bf16_t* xs; const float* nwn; const float* scn; unsigned long long* ssq; int dropx;
    const bf16_t* xsb; const float* nwb; const float* scb;
    __device__ __forceinline__ void operator()(const f32x4 (&acc)[2][2][4][2], const Unit& u, int wr, int wc, int fr, int fq) const {
        const int row0 = u.pm * BM + wr * 64 + fr, col0 = u.pn * BM + wc * 32 + 8 * fq;
        if (u.part >= 0) {
#pragma unroll
            for (int ai = 0; ai < 2; ++ai)
#pragma unroll
                for (int m = 0; m < 4; ++m) { float* sp = slab + ((size_t)u.part * 512 + (size_t)(row0 + ai * HALF + m * 16 - MPROWS)) * 1024 + col0;
#pragma unroll
                    for (int bj = 0; bj < 2; ++bj)
#pragma unroll
                        for (int n = 0; n < 2; ++n) *(f32x4*)(sp + bj * HALF + 4 * n) = acc[ai][bj][m][n]; }
            return; }
        f32x4 gs0[2], gs1[2];
        { const float* gp = gate + (size_t)bidx(u.pm * BM) * 9216 + col0;
#pragma unroll
          for (int bj = 0; bj < 2; ++bj) { gs0[bj] = *(const f32x4*)(gp + bj * HALF) * s; gs1[bj] = *(const f32x4*)(gp + bj * HALF + 4) * s; } }
        const bool fold = xs != nullptr && !dummy;
        float ssrow[8];
#pragma unroll
        for (int e = 0; e < 8; ++e) ssrow[e] = 0.f;
        f32x4 ig0[2], ig1[2];
        ig0[0] = ig0[1] = ig1[0] = ig1[1] = (f32x4){1.f, 1.f, 1.f, 1.f};
        if (xsb) { const float* sp = scb + (size_t)bidx(u.pm * BM) * 9216 + col0; const float* np = nwb + col0;
#pragma unroll
            for (int bj = 0; bj < 2; ++bj) { const f32x4 d0 = *(const f32x4*)(np + bj * HALF) * (*(const f32x4*)(sp + bj * HALF) + 1.0f), d1 = *(const f32x4*)(np + bj * HALF + 4) * (*(const f32x4*)(sp + bj * HALF + 4) + 1.0f);
#pragma unroll
                for (int e = 0; e < 4; ++e) { ig0[bj][e] = __builtin_amdgcn_rcpf(d0[e]); ig1[bj][e] = __builtin_amdgcn_rcpf(d1[e]); } } }
        f32x4 gn0[2], gn1[2];
        gn0[0] = gn0[1] = gn1[0] = gn1[1] = (f32x4){0.f, 0.f, 0.f, 0.f};
        if (fold) { const float* sp = scn + (size_t)bidx(u.pm * BM) * 9216 + col0; const float* np = nwn + col0;
#pragma unroll
            for (int bj = 0; bj < 2; ++bj) { gn0[bj] = *(const f32x4*)(np + bj * HALF) * (*(const f32x4*)(sp + bj * HALF) + 1.0f); gn1[bj] = *(const f32x4*)(np + bj * HALF + 4) * (*(const f32x4*)(sp + bj * HALF + 4) + 1.0f); } }
#pragma unroll
        for (int ai = 0; ai < 2; ++ai)
#pragma unroll
            for (int m = 0; m < 4; ++m) { const int row = row0 + ai * HALF + m * 16; const size_t xo = (size_t)row * 1024 + col0; float ssr = 0.f;
#pragma unroll
                for (int bj = 0; bj < 2; ++bj) { f32x4 b0, b1;
                    if (first) { const float* bp = (row < MPROWS ? base_p + (size_t)row * 1024 : base_s + (size_t)(row - MPROWS) * 1024) + col0 + bj * HALF; b0 = *(const f32x4*)bp; b1 = *(const f32x4*)(bp + 4); }
                    else { const u32x4 w = *(const u32x4*)((xsb ? xsb : xh) + xo + bj * HALF);
                        b0 = (f32x4){__uint_as_float(w.x << 16), __uint_as_float(w.x & 0xffff0000u), __uint_as_float(w.y << 16), __uint_as_float(w.y & 0xffff0000u)} * ig0[bj];
                        b1 = (f32x4){__uint_as_float(w.z << 16), __uint_as_float(w.z & 0xffff0000u), __uint_as_float(w.w << 16), __uint_as_float(w.w & 0xffff0000u)} * ig1[bj]; }
                    const f32x4 o0 = b0 + gs0[bj] * acc[ai][bj][m][0], o1 = b1 + gs1[bj] * acc[ai][bj][m][1];
                    if (last && !dummy) { *(f32x4*)(outf + xo + bj * HALF) = o0; *(f32x4*)(outf + xo + bj * HALF + 4) = o1; }
                    else if (!(fold && dropx)) { bf16_t* xw = dummy ? dummy : xh; u32x4 w; w.x = pk2(o0[0], o0[1]); w.y = pk2(o0[2], o0[3]); w.z = pk2(o1[0], o1[1]); w.w = pk2(o1[2], o1[3]); *(u32x4*)(xw + xo + bj * HALF) = w; }
                    if (fold) { const f32x4 y0 = o0 * gn0[bj], y1 = o1 * gn1[bj];
                        u32x4 w; w.x = pk2(y0[0], y0[1]); w.y = pk2(y0[2], y0[3]); w.z = pk2(y1[0], y1[1]); w.w = pk2(y1[2], y1[3]); *(u32x4*)(xs + xo + bj * HALF) = w;
                        ssr += ((o0[0] * o0[0] + o0[1] * o0[1]) + (o0[2] * o0[2] + o0[3] * o0[3])) + ((o1[0] * o1[0] + o1[1] * o1[1]) + (o1[2] * o1[2] + o1[3] * o1[3])); } }
                if (fold) ssrow[ai * 4 + m] = qsum(ssr);
                asm volatile("" ::: "memory"); }
        if (fold) {
#pragma unroll
            for (int g = 0; g < 2; ++g) { const int rg = 2 * fq + g;
                float v = ssrow[0];
#pragma unroll
                for (int e = 1; e < 8; ++e) v = (rg == e) ? ssrow[e] : v;
                (void)__hip_atomic_fetch_add(ssq + row0 + (rg >> 2) * HALF + (rg & 3) * 16, (unsigned long long)(v * 268435456.0f), __ATOMIC_RELAXED, __HIP_MEMORY_SCOPE_AGENT); } }
    }
};

struct EpiABin {
    static constexpr bool PERM = true, AFTER_DRAIN = false;
    static constexpr bool HAS_PRE = false; struct Pre {};
    bf16_t* U; size_t tstride; const float* qnw; const float* knw; float* pbk; float* pbv; float* sbk; float* sbv; float eps; int plain;
    __device__ __forceinline__ void operator()(const f32x4 (&acc)[2][2][4][2], const Unit& u, int wr, int wc, int fr, int fq) const {
        const int t = u.pn >> 1, half = u.pn & 1;
        bf16_t* dst = U + (size_t)t * tstride;
        const int row0 = u.pm * BM + wr * 64 + fr, lc0 = 256 * half + 64 * wc + 8 * fq;
        const bool norm = (t == 4 || t == 5) && !plain;
        f32x4 nw[2][2];
        if (norm) { const float* w = (t == 4) ? qnw : knw;
#pragma unroll
            for (int bj = 0; bj < 2; ++bj)
#pragma unroll
                for (int n = 0; n < 2; ++n) nw[bj][n] = *(const f32x4*)(w + 32 * bj + 8 * fq + 4 * n); }
        const bool is_s = u.pm >= 64, is_ptail = (!is_s) && ((u.pm & 7) >= 6);
        float* fo = nullptr;
        if (t == 5 && !plain) fo = is_s ? sbk : (is_ptail ? pbk : nullptr);
        if (t == 6 && !plain) fo = is_s ? sbv : (is_ptail ? pbv : nullptr);
#pragma unroll
        for (int ai = 0; ai < 2; ++ai)
#pragma unroll
            for (int m = 0; m < 4; ++m) { const int row = row0 + ai * HALF + m * 16;
                f32x4 v[2][2];
#pragma unroll
                for (int bj = 0; bj < 2; ++bj)
#pragma unroll
                    for (int n = 0; n < 2; ++n) v[bj][n] = acc[ai][bj][m][n];
                if (norm) { float ss = 0.f;
#pragma unroll
                    for (int bj = 0; bj < 2; ++bj)
#pragma unroll
                        for (int n = 0; n < 2; ++n) ss += (v[bj][n][0] * v[bj][n][0] + v[bj][n][1] * v[bj][n][1]) + (v[bj][n][2] * v[bj][n][2] + v[bj][n][3] * v[bj][n][3]);
                    ss = qsum(ss);
                    const float rstd = 1.0f / sqrtf(ss * (1.0f / 64.0f) + eps);
#pragma unroll
                    for (int bj = 0; bj < 2; ++bj)
#pragma unroll
                        for (int n = 0; n < 2; ++n) v[bj][n] = v[bj][n] * rstd * nw[bj][n]; }
                bf16_t* rowp = dst + (size_t)row * 512 + lc0;
#pragma unroll
                for (int bj = 0; bj < 2; ++bj) { u32x4 w; w.x = pk2(v[bj][0][0], v[bj][0][1]); w.y = pk2(v[bj][0][2], v[bj][0][3]); w.z = pk2(v[bj][1][0], v[bj][1][1]); w.w = pk2(v[bj][1][2], v[bj][1][3]);
                    *(u32x4*)(rowp + 32 * bj) = w; }
                if (fo) { size_t orow;
                    if (is_s) orow = (size_t)(row - MPROWS); else orow = (size_t)(row >> 11) * 512 + (size_t)((row & 2047) - 1536);
                    float* op = fo + orow * 512 + lc0;
#pragma unroll
                    for (int bj = 0; bj < 2; ++bj)
#pragma unroll
                        for (int n = 0; n < 2; ++n) *(f32x4*)(op + 32 * bj + 4 * n) = v[bj][n]; }
            }
    }
};

template <bool FOLDED>
struct EpiCinT {
    static constexpr bool PERM = true, AFTER_DRAIN = false;
    static constexpr bool HAS_PRE = FOLDED; struct Pre { unsigned long long q; float b; };
    bf16_t* GB; bf16_t* XB; float* pcc; float* scc;
    const unsigned long long* ssq; const float* bias; PG8_LAS float* tab;
    __device__ __forceinline__ Pre pre_load(const Unit& u, int tid) const {
        Pre p{0ull, 0.f};
        if (FOLDED) { const int pm = u.pm < 64 ? u.pm : 63, i = tid & 255; p.q = ssq[pm * BM + i]; p.b = bias[(size_t)(pm >> 3) * 2048 + u.pn * BM + i]; }
        return p; }
    __device__ __forceinline__ void pre_store(const Pre& p, int tid) const {
        if (FOLDED) { if (tid < 256) tab[tid] = __builtin_amdgcn_rsqf((float)p.q * (1.0f / (268435456.0f * 1024.0f)) + 1e-6f); else tab[tid] = p.b; } }
    __device__ __forceinline__ void operator()(const f32x4 (&acc)[2][2][4][2], const Unit& u, int wr, int wc, int fr, int fq) const {
        const bool isx = u.pn >= 4; bf16_t* dst = isx ? XB : GB;
        const int row0 = u.pm * BM + wr * 64 + fr, col0 = 256 * (u.pn & 3) + wc * 32 + 8 * fq;
        const bool is_s = u.pm >= 64;
        float rs[2][4]; f32x4 bb[2][2];
#pragma unroll
        for (int ai = 0; ai < 2; ++ai)
#pragma unroll
            for (int m = 0; m < 4; ++m) rs[ai][m] = 1.0f;
        bb[0][0] = bb[0][1] = bb[1][0] = bb[1][1] = (f32x4){0.f, 0.f, 0.f, 0.f};
        if (FOLDED && !is_s) {
#pragma unroll
            for (int ai = 0; ai < 2; ++ai)
#pragma unroll
                for (int m = 0; m < 4; ++m) rs[ai][m] = tab[ai * HALF + wr * 64 + m * 16 + fr];
            const PG8_LAS float* bp = tab + 256 + wc * 32 + 8 * fq;
            bb[0][0] = *(const PG8_LAS f32x4*)bp; bb[0][1] = *(const PG8_LAS f32x4*)(bp + 4); bb[1][0] = *(const PG8_LAS f32x4*)(bp + HALF); bb[1][1] = *(const PG8_LAS f32x4*)(bp + HALF + 4); }
#pragma unroll
        for (int ai = 0; ai < 2; ++ai)
#pragma unroll
            for (int m = 0; m < 4; ++m) { const int row = row0 + ai * HALF + m * 16; bf16_t* rowp = dst + (size_t)row * 1024 + col0;
                f32x4 vv[2][2];
#pragma unroll
                for (int bj = 0; bj < 2; ++bj)
#pragma unroll
                    for (int n = 0; n < 2; ++n) vv[bj][n] = FOLDED ? acc[ai][bj][m][n] * rs[ai][m] + bb[bj][n] : acc[ai][bj][m][n];
#pragma unroll
                for (int bj = 0; bj < 2; ++bj) { const f32x4 v0 = vv[bj][0], v1 = vv[bj][1];
                    u32x4 w; w.x = pk2(v0[0], v0[1]); w.y = pk2(v0[2], v0[3]); w.z = pk2(v1[0], v1[1]); w.w = pk2(v1[2], v1[3]);
                    *(u32x4*)(rowp + bj * HALF) = w; }
                if (isx) { float* op = nullptr;
                    if (is_s) { const int r = row - MPROWS, tt = r & 15; if (tt >= 13) op = scc + ((size_t)(r >> 4) * 3 + (tt - 13)) * 1024 + col0; }
                    else { const int tt = row & 2047; if (tt >= 2045) op = pcc + ((size_t)(row >> 11) * 3 + (tt - 2045)) * 1024 + col0; }
                    if (op) {
#pragma unroll
                        for (int bj = 0; bj < 2; ++bj)
#pragma unroll
                            for (int n = 0; n < 2; ++n) *(f32x4*)(op + bj * HALF + 4 * n) = vv[bj][n]; } }
            }
    }
};
typedef EpiCinT<false> EpiCin;
template <class Epi, class Sched, bool ALIGN_EPI = false, bool SP2 = false>
__device__ __forceinline__ void gemm_phase(PG8_LAS unsigned char* lds, const Gemm g, const Sched& S, const Epi& E, const int tid) {
    const int wid = __builtin_amdgcn_readfirstlane(tid >> 6), lane = tid & 63, wr = wid >> 2, wc = wid & 3, fr = lane & 15, fq = lane >> 4;
    const int K = g.K;
    unsigned voffA[2], voffB[2];
#pragma unroll
    for (int i = 0; i < 2; ++i) { int R, C; stage_rc(tid * 16 + i * 8192, R, C); const int Rb = Epi::PERM ? ((R & ~31) + perm32(R & 31)) : R;
        voffA[i] = (unsigned)(R * K + C) * 2u; voffB[i] = (unsigned)(Rb * K + C) * 2u; }
    const size_t kstep = (size_t)(BK * 2);
    const size_t hstep = (size_t)HALF * K * 2;
    const size_t tstep = 2 * hstep;
    const unsigned ldsw = (unsigned)wid * 1024u;
    const int aoff = lds_byte(wr * 64 + fr, fq * 8), boff = lds_byte(wc * 32 + fr, fq * 8);
#define PG8_SA(b, h) (((b) * 2 + (h)) * HTB)
#define PG8_SB(b, h) ((4 + (b) * 2 + (h)) * HTB)
#define PG8_STAGE(bufoff, gbase, voff) do { _Pragma("unroll") for (int _i = 0; _i < 2; ++_i) \
        __builtin_amdgcn_global_load_lds((const unsigned*)((const char*)(gbase) + (voff)[_i]), (PG8_LAS unsigned*)(lds + (bufoff) + ldsw + _i * 8192), 16, 0, 0); } while (0)
#define PG8_LDA(dst, b, h) do { _Pragma("unroll") for (int m = 0; m < 4; ++m) _Pragma("unroll") for (int k = 0; k < 2; ++k) dst[m][k] = *(const PG8_LAS bf16x8*)(lds + PG8_SA(b, h) + aoff + m * 2048 + k * 1024); } while (0)
#define PG8_LDB(dst, b, h) do { _Pragma("unroll") for (int n = 0; n < 2; ++n) _Pragma("unroll") for (int k = 0; k < 2; ++k) dst[n][k] = *(const PG8_LAS bf16x8*)(lds + PG8_SB(b, h) + boff + n * 2048 + k * 1024); } while (0)
#define PG8_MMA(ai, bj, At, Bt) do { __builtin_amdgcn_s_setprio(1); _Pragma("unroll") for (int m = 0; m < 4; ++m) _Pragma("unroll") for (int n = 0; n < 2; ++n) _Pragma("unroll") for (int k = 0; k < 2; ++k) \
        acc[ai][bj][m][n] = __builtin_amdgcn_mfma_f32_16x16x32_bf16(Bt[n][k], At[m][k], acc[ai][bj][m][n], 0, 0, 0); __builtin_amdgcn_s_setprio(0); } while (0)
#define PG8_WAIT_V(n) asm volatile("s_waitcnt vmcnt(" #n ")" ::: "memory")
#define PG8_WAIT_L(n) asm volatile("s_waitcnt lgkmcnt(" #n ")" ::: "memory")
#define PG8_BAR __builtin_amdgcn_s_barrier()
#define PG8_SCHED __builtin_amdgcn_sched_barrier(0)
    Unit cur, nxt; int ui = 0;
    if (!S.next(0, cur)) return;
    f32x4 acc[2][2][4][2];
#pragma unroll
    for (int a = 0; a < 2; ++a)
#pragma unroll
        for (int b = 0; b < 2; ++b)
#pragma unroll
            for (int m = 0; m < 4; ++m)
#pragma unroll
                for (int n = 0; n < 2; ++n) acc[a][b][m][n] = (f32x4){0.f, 0.f, 0.f, 0.f};
    bf16x8 At[4][2], B0[2][2], B1[2][2];
    const char* cA = (const char*)g.A + (size_t)cur.pm * tstep + (size_t)S.k0(cur) * kstep; const char* cB = (const char*)g.Bt + (size_t)cur.pn * tstep + (size_t)S.k0(cur) * kstep;
    S.a_ready(cur, wid);
    if constexpr (SP2) {
        PG8_STAGE(PG8_SB(0, 0), cB, voffB); PG8_STAGE(PG8_SB(0, 1), cB + hstep, voffB); PG8_STAGE(PG8_SA(0, 0), cA, voffA); PG8_STAGE(PG8_SA(0, 1), cA + hstep, voffA);
        if (wr == 1) PG8_BAR;
        PG8_WAIT_V(2); PG8_BAR;
        PG8_STAGE(PG8_SB(1, 0), cB + kstep, voffB); PG8_STAGE(PG8_SA(1, 0), cA + kstep, voffA); PG8_STAGE(PG8_SB(1, 1), cB + hstep + kstep, voffB);
        PG8_WAIT_V(6); PG8_BAR;
    } else {
        PG8_STAGE(PG8_SB(0, 0), cB, voffB); PG8_STAGE(PG8_SA(0, 0), cA, voffA); PG8_STAGE(PG8_SB(0, 1), cB + hstep, voffB); PG8_STAGE(PG8_SA(0, 1), cA + hstep, voffA);
        if (wr == 1) PG8_BAR;
        PG8_WAIT_V(4); PG8_BAR;
        PG8_STAGE(PG8_SB(1, 0), cB + kstep, voffB); PG8_STAGE(PG8_SA(1, 0), cA + kstep, voffA); PG8_STAGE(PG8_SB(1, 1), cB + hstep + kstep, voffB);
        PG8_WAIT_V(6); PG8_BAR;
    }
    for (;;) {
        const bool has_next = S.next(ui + 1, nxt);
        const char* nA = has_next ? (const char*)g.A + (size_t)nxt.pm * tstep + (size_t)S.k0(nxt) * kstep : cA; const char* nB = has_next ? (const char*)g.Bt + (size_t)nxt.pn * tstep + (size_t)S.k0(nxt) * kstep : cB;
        const int nt = S.nt(cur);
        for (int t = 0; t < nt; t += 2) {
            const bool last = (t == nt - 2);
            const char* a1 = cA + (size_t)(t + 1) * kstep;
            const char* a2 = last ? nA : cA + (size_t)(t + 2) * kstep; const char* b2 = last ? nB : cB + (size_t)(t + 2) * kstep;
            const char* a3 = a2 + kstep; const char* b3 = b2 + kstep;
            if (last && has_next) S.a_ready(nxt, wid);
            typename Epi::Pre pre{};
            if constexpr (Epi::HAS_PRE) { if (last) pre = E.pre_load(cur, tid); }
            if constexpr (SP2) {
            PG8_LDB(B0, 0, 0); PG8_LDB(B1, 0, 1); PG8_SCHED; PG8_LDA(At, 0, 0); PG8_STAGE(PG8_SA(1, 1), a1 + hstep, voffA);
            PG8_WAIT_V(8); PG8_WAIT_L(0); PG8_BAR; PG8_MMA(0, 0, At, B0); PG8_MMA(0, 1, At, B1); PG8_BAR; PG8_SCHED;
            PG8_LDA(At, 0, 1); PG8_STAGE(PG8_SB(0, 0), b2, voffB); PG8_STAGE(PG8_SB(0, 1), b2 + hstep, voffB); PG8_STAGE(PG8_SA(0, 0), a2, voffA);
            PG8_WAIT_V(8); PG8_WAIT_L(0); PG8_BAR; PG8_MMA(1, 0, At, B0); PG8_MMA(1, 1, At, B1); PG8_BAR; PG8_SCHED;
            PG8_LDB(B0, 1, 0); PG8_LDB(B1, 1, 1); PG8_SCHED; PG8_LDA(At, 1, 0); PG8_STAGE(PG8_SA(0, 1), a2 + hstep, voffA);
            PG8_WAIT_V(8); PG8_WAIT_L(0); PG8_BAR; PG8_MMA(0, 0, At, B0); PG8_MMA(0, 1, At, B1); PG8_BAR; PG8_SCHED;
            PG8_LDA(At, 1, 1); PG8_STAGE(PG8_SB(1, 0), b3, voffB); PG8_STAGE(PG8_SB(1, 1), b3 + hstep, voffB); PG8_STAGE(PG8_SA(1, 0), a3, voffA);
            PG8_WAIT_V(8); PG8_WAIT_L(0); PG8_BAR; PG8_MMA(1, 0, At, B0); PG8_MMA(1, 1, At, B1);
            if constexpr (Epi::HAS_PRE) { if (last) { E.pre_store(pre, tid); PG8_WAIT_L(0); } }
            PG8_BAR; PG8_SCHED;
            } else {
            PG8_LDB(B0, 0, 0); PG8_SCHED; PG8_LDA(At, 0, 0); PG8_STAGE(PG8_SA(1, 1), a1 + hstep, voffA);
            PG8_WAIT_L(8); PG8_BAR; PG8_WAIT_L(0); PG8_MMA(0, 0, At, B0); PG8_BAR; PG8_SCHED;
            PG8_LDB(B1, 0, 1); PG8_STAGE(PG8_SB(0, 0), b2, voffB);
            PG8_BAR; PG8_WAIT_L(0); PG8_MMA(0, 1, At, B1); PG8_BAR;
            PG8_LDA(At, 0, 1); PG8_STAGE(PG8_SA(0, 0), a2, voffA);
            PG8_BAR; PG8_WAIT_L(0); PG8_MMA(1, 0, At, B0); PG8_BAR; PG8_SCHED;
            PG8_STAGE(PG8_SB(0, 1), b2 + hstep, voffB);
            PG8_WAIT_V(6); PG8_BAR; PG8_MMA(1, 1, At, B1); PG8_BAR;
            PG8_LDB(B0, 1, 0); PG8_SCHED; PG8_LDA(At, 1, 0); PG8_STAGE(PG8_SA(0, 1), a2 + hstep, voffA);
            PG8_WAIT_L(8); PG8_BAR; PG8_WAIT_L(0); PG8_MMA(0, 0, At, B0); PG8_BAR; PG8_SCHED;
            PG8_LDB(B1, 1, 1); PG8_STAGE(PG8_SB(1, 0), b3, voffB);
            PG8_BAR; PG8_WAIT_L(0); PG8_MMA(0, 1, At, B1); PG8_BAR;
            PG8_LDA(At, 1, 1); PG8_STAGE(PG8_SA(1, 0), a3, voffA);
            PG8_BAR; PG8_WAIT_L(0); PG8_MMA(1, 0, At, B0); PG8_BAR; PG8_SCHED;
            PG8_STAGE(PG8_SB(1, 1), b3 + hstep, voffB);
            PG8_WAIT_V(6); PG8_BAR; PG8_MMA(1, 1, At, B1); PG8_BAR;
            }
        }
        if constexpr (ALIGN_EPI) { if (wr == 0) PG8_BAR; }
        if constexpr (!Epi::AFTER_DRAIN) { E(acc, cur, wr, wc, fr, fq); S.done(cur); }
        if (!has_next) break;
#pragma unroll
        for (int a = 0; a < 2; ++a)
#pragma unroll
            for (int b = 0; b < 2; ++b)
#pragma unroll
                for (int m = 0; m < 4; ++m)
#pragma unroll
                    for (int n = 0; n < 2; ++n) acc[a][b][m][n] = (f32x4){0.f, 0.f, 0.f, 0.f};
        cur = nxt; cA = nA; cB = nB; ++ui;
        if constexpr (ALIGN_EPI) { if (wr == 1) PG8_BAR; }
    }
    PG8_WAIT_V(0);
    if constexpr (!ALIGN_EPI) { if (wr == 0) PG8_BAR; }
    PG8_BAR;
    if constexpr (Epi::AFTER_DRAIN) { E.fused(acc, cur, wr, wc, fr, fq, lds, wid, lane); S.done(cur); }
#undef PG8_SA
#undef PG8_SB
#undef PG8_STAGE
#undef PG8_LDA
#undef PG8_LDB
#undef PG8_MMA
#undef PG8_WAIT_V
#undef PG8_WAIT_L
#undef PG8_BAR
#undef PG8_SCHED
}
}
#define GAS __attribute__((address_space(1)))
#define LAS __attribute__((address_space(3)))
typedef unsigned short bf16;
typedef unsigned v4u __attribute__((ext_vector_type(4)));
typedef float f32x4 __attribute__((ext_vector_type(4)));
typedef short bf16x8 __attribute__((ext_vector_type(8)));
typedef GAS unsigned gu32;
typedef GAS unsigned long long gu64;
#define RLX_AGENT __ATOMIC_RELAXED, __HIP_MEMORY_SCOPE_AGENT
#define LDS_WAIT() asm volatile("s_waitcnt lgkmcnt(0)" ::: "memory")
#define VM_WAIT() asm volatile("s_waitcnt vmcnt(0)" ::: "memory")
__device__ __forceinline__ unsigned long long rt() { return __builtin_amdgcn_s_memrealtime(); }

#define XB_TMO      128
#define XB_XCNT(j)  (256  + 64 * (j))
#define XB_XSUB(j)  (1280 + 64 * (j))
#define XB_XGEN(j)  (2304 + 64 * (j))
#define XB_TOP      3328
#define XB_TOPGEN   3392
#define XCD_BAR_WORDS 3456
#define XB_SPIN_CAP (1u << 18)

__device__ __forceinline__ unsigned xb_ld(unsigned* p)              { return __hip_atomic_load(p, __ATOMIC_RELAXED, __HIP_MEMORY_SCOPE_AGENT); }
__device__ __forceinline__ unsigned xb_add(unsigned* p, unsigned v) { return __hip_atomic_fetch_add(p, v, __ATOMIC_RELAXED, __HIP_MEMORY_SCOPE_AGENT); }
__device__ __forceinline__ unsigned xb_xcc_id() { return (unsigned)__builtin_amdgcn_s_getreg((3 << 11) | 20) & 0xFu; }
#define XB_SPIN(cond, bar) do { unsigned _sp = 0; while (cond) { __builtin_amdgcn_s_sleep(1); \
    if ((++_sp & 255u) == 0u) { if (xb_ld(&(bar)[XB_TMO])) break; if (_sp > XB_SPIN_CAP) { atomicAdd(&(bar)[XB_TMO], 1u); break; } } } } while (0)

struct XcdBarrier {
    unsigned* bar; unsigned x;
    volatile LAS unsigned* st;
};

__device__ __forceinline__ XcdBarrier xcd_barrier_post(unsigned* bar, volatile LAS unsigned* st) {
    XcdBarrier b; b.bar = bar; b.x = xb_xcc_id(); b.st = st;
    if (threadIdx.x == 0) (void)xb_add(&bar[XB_XCNT(b.x)], 1u);
    return b;
}
__device__ __forceinline__ void xcd_barrier_complete(unsigned* bar, unsigned x, unsigned& nloc, unsigned& nx) {
    const unsigned G = gridDim.x * gridDim.y * gridDim.z;
    unsigned sum, cnt, mine, sp = 0u;
    for (;;) {
        sum = 0u; cnt = 0u; mine = 0u;
#pragma unroll
        for (unsigned j = 0; j < 16; ++j) { const unsigned c = xb_ld(&bar[XB_XCNT(j)]); sum += c; cnt += (c > 0u) ? 1u : 0u; mine = (j == x) ? c : mine; }
        if (sum == G) break;
        __builtin_amdgcn_s_sleep(1);
        if ((++sp & 255u) == 0u) { if (xb_ld(&bar[XB_TMO])) break; if (sp > XB_SPIN_CAP) { atomicAdd(&bar[XB_TMO], 1u); break; } }
    }
    nloc = mine > 0u ? mine : 1u; nx = cnt > 0u ? cnt : 1u;
}

__device__ __forceinline__ void xcd_barrier(const XcdBarrier& b, const bool leader_thread) {
    asm volatile("s_waitcnt vmcnt(0)" ::: "memory");
    __syncthreads();
    if (leader_thread) {
        unsigned* bar = b.bar;
        __builtin_amdgcn_s_waitcnt(0);
        unsigned nloc = b.st[0], nx = b.st[1];
        if (nloc == 0u) { xcd_barrier_complete(bar, b.x, nloc, nx); b.st[0] = nloc; b.st[1] = nx; }
        const unsigned old = xb_add(&bar[XB_XSUB(b.x)], 1u);
        const unsigned gen = old / nloc;
        if (old + 1u == (gen + 1u) * nloc) {
            __builtin_amdgcn_fence(__ATOMIC_RELEASE, "agent");
            asm volatile("s_waitcnt vmcnt(0)" ::: "memory");
            const unsigned og = xb_add(&bar[XB_TOP], 1u);
            const unsigned tg = og / nx;
            if (og + 1u == (tg + 1u) * nx) xb_add(&bar[XB_TOPGEN], 1u);
            else XB_SPIN(xb_ld(&bar[XB_TOPGEN]) == tg, bar);
            __builtin_amdgcn_fence(__ATOMIC_ACQUIRE, "agent");
            xb_add(&bar[XB_XGEN(b.x)], 1u);
            asm volatile("s_waitcnt vmcnt(0)" ::: "memory");
        } else {
            XB_SPIN(xb_ld(&bar[XB_XGEN(b.x)]) == gen, bar);
            __builtin_amdgcn_fence(__ATOMIC_ACQUIRE, "agent");
            asm volatile("s_waitcnt vmcnt(0)" ::: "memory");
        }
    }
    __syncthreads();
}
constexpr int NWAVES = 8;
constexpr int MP = 16384, MS = 512, MT = 16896, D = 1024, DFF = 2816, NADA = 9216, NBR = 40;
constexpr float EPS = 1e-6f;
constexpr size_t MiB = 1u << 20;
constexpr size_t WS_CTL = 0, CTL_ZERO_BYTES = 1 * MiB;
constexpr size_t WS_ADAP = 1 * MiB;
constexpr int NKS = 4;
constexpr size_t WS_ADA = 24 * MiB;
constexpr size_t WS_GA = 27 * MiB;
constexpr size_t WS_CARRY = 28 * MiB;
constexpr size_t WS_WFIN = 32 * MiB;
constexpr size_t WS_WFOUT = 76 * MiB;
constexpr size_t WS_WABIN = 98 * MiB;
constexpr size_t WS_WABOUT = 105 * MiB;
constexpr size_t WS_WCIN = 107 * MiB;
constexpr size_t WS_WCOUT = 111 * MiB;
constexpr size_t WS_WGATE = 113 * MiB;
constexpr size_t WS_XN = 114 * MiB;
constexpr size_t WS_BIG = 147 * MiB;
constexpr size_t WS_SLAB = 1 * MiB;
constexpr size_t WS_H2 = 180 * MiB;
constexpr size_t WS_BIAS = 280 * MiB;
constexpr size_t WS_BIASC = 30 * MiB;
constexpr size_t WS_XS3 = 246 * MiB;
constexpr size_t CTL_SSQ = 65536;
constexpr size_t CTL_SCTR = 32768;
constexpr size_t WS_XR = 286 * MiB;
constexpr size_t WS_END = 320 * MiB;
constexpr size_t FIN_ELEMS = (size_t)5632 * 1024, FOUT_ELEMS = (size_t)1024 * 2816, U_ELEMS = (size_t)MT * 512;
constexpr int CW_BAR = 4096;
constexpr size_t O_YP = 0, O_YS = 16777216, O_PAC = 17301504, O_PAN = 17825792, O_PAM = 17829888, O_PBK = 17829920, O_PBV = 19927072, O_PCC = 22024224, O_PCH = 22048800,
                 O_SAC = 22056992, O_SAN = 24154144, O_SAM = 24170528, O_SBK = 24170656, O_SBV = 24432800, O_SCC = 24694944, O_SCH = 24793248, O_TOTAL = 24826016;
constexpr int RING_BYTES = 131072, LDSCTL_OFF = RING_BYTES, MISC_OFF = LDSCTL_OFF + 320, LDS_BYTES = 147456;

typedef short s16x4 __attribute__((ext_vector_type(4)));
typedef unsigned u32x2 __attribute__((ext_vector_type(2)));
using pg8::pk2; using pg8::bidx; using pg8::fast_sigmoid; using pg8::wave_sum; using pg8::wave_max; using pg8::scan_add; using pg8::scan_max; using pg8::qsum; using pg8::qmax; using pg8::bperm; using pg8::rdlane; using pg8::rsum8;
__device__ __forceinline__ float bf2f(unsigned short u) { return __uint_as_float(((unsigned)u) << 16); }
__device__ __forceinline__ float bflo(unsigned w) { return __uint_as_float(w << 16); }
__device__ __forceinline__ float bfhi(unsigned w) { return __uint_as_float(w & 0xffff0000u); }
#define LDS_BARRIER() do { asm volatile("s_waitcnt lgkmcnt(0)" ::: "memory"); __builtin_amdgcn_s_barrier(); asm volatile("" ::: "memory"); } while (0)
__device__ __forceinline__ f32x4 mfma16(bf16x8 a, bf16x8 b, f32x4 c) { return __builtin_amdgcn_mfma_f32_16x16x32_bf16(a, b, c, 0, 0, 0); }
typedef short v4i16_t __attribute__((ext_vector_type(4)));
__device__ __forceinline__ s16x4 ldtr(const LAS unsigned short* p) { return __builtin_bit_cast(s16x4, __builtin_amdgcn_ds_read_tr16_b64_v4i16((LAS v4i16_t*)p)); }
__device__ __forceinline__ bf16x8 cat8(s16x4 a, s16x4 b) { return (bf16x8){a[0], a[1], a[2], a[3], b[0], b[1], b[2], b[3]}; }

#ifndef DUP
#define DUP 0
#endif
#ifndef FOLD
#define FOLD 15
#endif
#ifndef FOLD_RES
#define FOLD_RES FOLD
#endif
#define NREP(k) ((DUP == (k)) ? 2 : 1)
__device__ __forceinline__ void p0_ada_item(const float* cP, const float* cS, const float* adaw, float* part, LAS float* cs, int item, int tid) {
    const int cb = item % 18, ks = item / 18, l = cb / 9, n = (cb % 9) * 1024 + tid * 2, k0 = ks * 128;
    for (int idx = tid; idx < 128 * NBR; idx += 512) { const int b = idx >> 7, kk = idx & 127; const float* c = b < 8 ? cP + b * 1024 : cS + (b - 8) * 1024; cs[kk * NBR + b] = c[k0 + kk]; }
    __syncthreads();
    float ax[NBR], ay[NBR];
#pragma unroll
    for (int b = 0; b < NBR; ++b) { ax[b] = 0.f; ay[b] = 0.f; }
    const float* wp = adaw + ((size_t)l * 1024 + k0) * NADA + n;
    float2 wn[16];
#pragma unroll
    for (int j = 0; j < 16; ++j) wn[j] = *(const float2*)(wp + (size_t)j * NADA);
    for (int k8 = 0; k8 < 128; k8 += 16) {
        float2 wc[16];
#pragma unroll
        for (int j = 0; j < 16; ++j) wc[j] = wn[j];
        if (k8 + 16 < 128) {
#pragma unroll
            for (int j = 0; j < 16; ++j) wn[j] = *(const float2*)(wp + (size_t)(k8 + 16 + j) * NADA); }
#pragma unroll
        for (int j = 0; j < 16; ++j) { const LAS f32x4* c4 = (const LAS f32x4*)(cs + (k8 + j) * NBR);
#pragma unroll
            for (int b4 = 0; b4 < NBR / 4; ++b4) { const f32x4 cv = c4[b4];
#pragma unroll
                for (int e = 0; e < 4; ++e) { ax[4 * b4 + e] += cv[e] * wc[j].x; ay[4 * b4 + e] += cv[e] * wc[j].y; } } } }
    float* pp = part + ((size_t)(ks * 2 + l) * NBR) * NADA + n;
#pragma unroll
    for (int b = 0; b < NBR; ++b) *(float2*)(pp + (size_t)b * NADA) = make_float2(ax[b], ay[b]);
    __syncthreads();
}
__device__ __forceinline__ void p0_ada_mfma(const float* cP, const float* cS, const float* adaw, float* part, LAS unsigned char* lds, int wg, int tid) {
    const int lane = tid & 63, w = __builtin_amdgcn_readfirstlane(tid >> 6), li = lane & 15, q = lane >> 4;
    const int kq = wg >> 6;
    LAS unsigned short* csh = (LAS unsigned short*)lds; LAS unsigned short* csl = csh + 48 * 264;
    LDS_BARRIER();
    { f32x4 v[5];
#pragma unroll
      for (int j = 0; j < 5; ++j) { const int i = tid + 512 * j, b = i >> 6, c4 = i & 63; const float* c = b < 8 ? cP + b * 1024 : cS + (b - 8) * 1024; v[j] = *(const f32x4*)(c + 256 * kq + 4 * c4); }
#pragma unroll
      for (int j = 0; j < 5; ++j) { const int i = tid + 512 * j, b = i >> 6, c4 = i & 63; u32x2 h, l; h.x = pk2(v[j][0], v[j][1]); h.y = pk2(v[j][2], v[j][3]);
          l.x = pk2(v[j][0] - bflo(h.x), v[j][1] - bfhi(h.x)); l.y = pk2(v[j][2] - bflo(h.y), v[j][3] - bfhi(h.y));
          *(LAS u32x2*)(csh + b * 264 + 4 * c4) = h; *(LAS u32x2*)(csl + b * 264 + 4 * c4) = l; } }
    LDS_BARRIER();
    for (int it = w; it < 18; it += NWAVES) {
        const int t = (18 * wg + it) % 1152, l = t / 576, n0 = (t % 576) * 16;
        const float* wp = adaw + ((size_t)l * 1024 + 256 * kq) * NADA + n0;
        const unsigned voff = (unsigned)(8 * q * NADA + li);
        float wv[8][8];
#pragma unroll
        for (int ks = 0; ks < 8; ++ks)
#pragma unroll
            for (int j = 0; j < 8; ++j) { const GAS float* rp = (const GAS float*)(wp + (size_t)(32 * ks + j) * NADA); asm volatile("" : "+s"(rp)); wv[ks][j] = rp[voff]; }
        f32x4 acc[3];
#pragma unroll
        for (int bt = 0; bt < 3; ++bt) acc[bt] = (f32x4){0.f, 0.f, 0.f, 0.f};
#pragma unroll
        for (int ks = 0; ks < 8; ++ks) {
            v4u hi, lo; hi.x = pk2(wv[ks][0], wv[ks][1]); hi.y = pk2(wv[ks][2], wv[ks][3]); hi.z = pk2(wv[ks][4], wv[ks][5]); hi.w = pk2(wv[ks][6], wv[ks][7]);
            lo.x = pk2(wv[ks][0] - bflo(hi.x), wv[ks][1] - bfhi(hi.x)); lo.y = pk2(wv[ks][2] - bflo(hi.y), wv[ks][3] - bfhi(hi.y));
            lo.z = pk2(wv[ks][4] - bflo(hi.z), wv[ks][5] - bfhi(hi.z)); lo.w = pk2(wv[ks][6] - bflo(hi.w), wv[ks][7] - bfhi(hi.w));
            const bf16x8 ah = __builtin_bit_cast(bf16x8, hi), al = __builtin_bit_cast(bf16x8, lo);
#pragma unroll
            for (int bt = 0; bt < 3; ++bt) { const int bo = (16 * bt + li) * 264 + 32 * ks + 8 * q;
                const bf16x8 bh = *(const LAS bf16x8*)(csh + bo), bl = *(const LAS bf16x8*)(csl + bo);
                acc[bt] = mfma16(ah, bh, acc[bt]); acc[bt] = mfma16(al, bh, acc[bt]); acc[bt] = mfma16(ah, bl, acc[bt]); } }
#pragma unroll
        for (int bt = 0; bt < 3; ++bt) { const int b = 16 * bt + li;
            if (b < NBR) *(f32x4*)(part + ((size_t)(kq * 2 + l) * NBR + b) * NADA + n0 + 4 * q) = acc[bt]; }
    }
}
struct Args { const float* in[34]; float* out; unsigned char* ws; };
struct Ctx { float* out; unsigned char* ws; };
__device__ __forceinline__ const float* inptr(int i) {
    const float* const __attribute__((address_space(4)))* p = (const float* const __attribute__((address_space(4)))*)__builtin_amdgcn_kernarg_segment_ptr();
    asm volatile("" : "+s"(p));
    return (const float*)(const GAS float*)p[i]; }
constexpr int TR_IFIN = 16 * 176, TR_IFOUT = 44 * 32, TR_IABIN = 16 * 112, TR_ISQ = 16 * 32, TR_ICIN = 16 * 64, TR_IGATE = 8 * 16;
__device__ __forceinline__ int tr_count(int st) { return st == 0 ? TR_IFIN + TR_IFOUT : st == 1 ? TR_IABIN + TR_ISQ : st == 2 ? TR_IFIN + TR_IFOUT : 2 * TR_IFIN + 2 * TR_IFOUT + TR_ICIN + TR_ISQ + TR_IGATE; }
__device__ __forceinline__ void tr_fin(int r, int f, unsigned char* ws, const float*& W, unsigned short*& WT, int& ldw, int& c0, int& k0, int& r0, int& Kd, float& wsc) {
    const int kb = r / 176, nb = r % 176, n0 = 32 * nb;
    W = inptr((f >> 1) ? 16 : 12) + (size_t)(f & 1) * 1024 * 5632; ldw = 5632; c0 = n0; k0 = 64 * kb; WT = (unsigned short*)(ws + WS_WFIN) + (size_t)f * FIN_ELEMS; Kd = 1024;
    r0 = n0 < DFF ? 256 * (n0 >> 7) + (n0 & 127) : 256 * ((n0 - DFF) >> 7) + 128 + ((n0 - DFF) & 127);
    wsc = n0 < DFF ? -1.4426950408889634f : -0.6931471805599453f; }
__device__ __forceinline__ void tr_fout(int r, int f, unsigned char* ws, const float*& W, unsigned short*& WT, int& ldw, int& c0, int& k0, int& r0, int& Kd) {
    const int kb = r / 32, nb = r % 32;
    W = inptr((f >> 1) ? 17 : 13) + (size_t)(f & 1) * DFF * 1024; ldw = 1024; c0 = 32 * nb; k0 = 64 * kb; WT = (unsigned short*)(ws + WS_WFOUT) + (size_t)f * FOUT_ELEMS; r0 = 32 * nb; Kd = DFF; }
__device__ __forceinline__ void tr_decode(int it, int st, unsigned char* ws, const float*& W, unsigned short*& WT, int& ldw, int& c0, int& k0, int& r0, int& Kd, float& wsc) {
    int r = it; wsc = 1.0f;
    if (st == 0 || st == 2) { const int f = st;
        if (r < TR_IFIN) { tr_fin(r, f, ws, W, WT, ldw, c0, k0, r0, Kd, wsc); return; }
        tr_fout(r - TR_IFIN, f, ws, W, WT, ldw, c0, k0, r0, Kd); return; }
    if (st == 1) {
        if (r < TR_IABIN) { const int kb = r / 112, nb = r % 112, L0 = 32 * nb, l = L0 & 255;
            W = inptr(20); ldw = 3592; c0 = L0 < 2048 ? L0 : L0 + 8; k0 = 64 * kb; WT = (unsigned short*)(ws + WS_WABIN); r0 = 256 * (L0 >> 8) + 128 * ((l >> 5) & 1) + 32 * (l >> 6); Kd = 1024; return; }
        r -= TR_IABIN;
        W = inptr(26); ldw = 1024; c0 = 32 * (r % 32); k0 = 64 * (r / 32); WT = (unsigned short*)(ws + WS_WABOUT); r0 = c0; Kd = 1024; return; }
    if (r < 2 * TR_IFIN) { tr_fin(r % TR_IFIN, 2 * (r / TR_IFIN) + 1, ws, W, WT, ldw, c0, k0, r0, Kd, wsc); return; }
    r -= 2 * TR_IFIN;
    if (r < 2 * TR_IFOUT) { tr_fout(r % TR_IFOUT, 2 * (r / TR_IFOUT) + 1, ws, W, WT, ldw, c0, k0, r0, Kd); return; }
    r -= 2 * TR_IFOUT;
    if (r < TR_ICIN) { W = inptr(27); ldw = 2048; c0 = 32 * (r % 64); k0 = 64 * (r / 64); WT = (unsigned short*)(ws + WS_WCIN); r0 = c0; Kd = 1024; return; }
    r -= TR_ICIN;
    if (r < TR_ISQ) { W = inptr(33); ldw = 1024; c0 = 32 * (r % 32); k0 = 64 * (r / 32); WT = (unsigned short*)(ws + WS_WCOUT); r0 = c0; Kd = 1024; return; }
    r -= TR_ISQ;
    { const int blk = r >> 4, kb = (r >> 3) & 1, nb = r & 7;
      W = inptr(30) + (size_t)blk * 128 * 256; ldw = 256; c0 = 32 * nb; k0 = 64 * kb; WT = (unsigned short*)(ws + WS_WGATE) + (size_t)blk * 256 * 128; r0 = c0; Kd = 128; }
}
__device__ __forceinline__ void p0_weights(const Ctx& A, LAS float* scr, int st, int gw, int NGW, int lane, int lo = 0, int hi = -1) {
    unsigned char* ws = A.ws;
    const int NITEMS = hi < 0 ? tr_count(st) : hi;
    const float* W; unsigned short* WT; int ldw, c0, k0, r0, Kd; float wsc;
    float cur[32], nxt[32];
    int it = lo + gw;
    if (it < NITEMS) { tr_decode(it, st, ws, W, WT, ldw, c0, k0, r0, Kd, wsc);
#pragma unroll
        for (int i = 0; i < 32; ++i) nxt[i] = W[(size_t)(k0 + 2 * i + (lane >> 5)) * ldw + c0 + (lane & 31)]; }
    for (; it < NITEMS; it += NGW) {
        unsigned short* WTc = WT; const int r0c = r0, Kdc = Kd, k0c = k0; const float wscc = wsc;
#pragma unroll
        for (int i = 0; i < 32; ++i) cur[i] = nxt[i];
        if (it + NGW < NITEMS) { tr_decode(it + NGW, st, ws, W, WT, ldw, c0, k0, r0, Kd, wsc);
#pragma unroll
            for (int i = 0; i < 32; ++i) nxt[i] = W[(size_t)(k0 + 2 * i + (lane >> 5)) * ldw + c0 + (lane & 31)]; }
#pragma unroll
        for (int i = 0; i < 32; ++i) scr[(2 * i + (lane >> 5)) * 33 + (lane & 31)] = cur[i] * wscc;
        LDS_WAIT(); asm volatile("" ::: "memory");
        const int c = lane & 7;
#pragma unroll
        for (int j = 0; j < 4; ++j) { const int n = (lane >> 3) + 8 * j; const LAS float* s = scr + (8 * c) * 33 + n;
            v4u o; o.x = pk2(s[0 * 33], s[1 * 33]); o.y = pk2(s[2 * 33], s[3 * 33]); o.z = pk2(s[4 * 33], s[5 * 33]); o.w = pk2(s[6 * 33], s[7 * 33]);
            *(GAS v4u*)(WTc + (size_t)(r0c + n) * Kdc + k0c + 8 * c) = o; }
        LDS_WAIT(); asm volatile("" ::: "memory");
    }
}

template <bool GATES, bool PLDS>
__device__ __forceinline__ void norm_row(f32x4 (&v)[4], int row, const float* nw, const float* adaL, int j3, unsigned short* XN, const float* gbias, float* GA, const LAS float* wg, const LAS float* pl, int lane) {
    f32x4 g[4], s1[4], s0[4];
    if (PLDS) {
#pragma unroll
        for (int j = 0; j < 4; ++j) { const int col = j * 256 + lane * 4; g[j] = *(const LAS f32x4*)(pl + col); s0[j] = *(const LAS f32x4*)(pl + 1024 + col); s1[j] = (f32x4){0.f, 0.f, 0.f, 0.f}; }
    } else {
        const int b = bidx(row); const float* sh = adaL + (size_t)b * NADA + j3 * 1024; const float* sc = sh + 1024;
#pragma unroll
        for (int j = 0; j < 4; ++j) { const int col = j * 256 + lane * 4; g[j] = *(const f32x4*)(nw + col); s1[j] = *(const f32x4*)(sc + col); s0[j] = *(const f32x4*)(sh + col); } }
    float ss = 0.f;
#pragma unroll
    for (int j = 0; j < 4; ++j) ss += (v[j][0] * v[j][0] + v[j][1] * v[j][1]) + (v[j][2] * v[j][2] + v[j][3] * v[j][3]);
    const float rstd = __builtin_amdgcn_rsqf(wave_sum(ss) * (1.0f / D) + EPS);
    float ga[8];
#pragma unroll
    for (int e = 0; e < 8; ++e) ga[e] = 0.f;
#pragma unroll
    for (int j = 0; j < 4; ++j) { const int col = j * 256 + lane * 4;
        const f32x4 y = v[j] * rstd * g[j] * (s1[j] + 1.0f) + s0[j];
        u32x2 o; o.x = pk2(y[0], y[1]); o.y = pk2(y[2], y[3]);
        *(u32x2*)(XN + (size_t)row * D + col) = o;
        if (GATES) {
#pragma unroll
            for (int e = 0; e < 4; ++e) { const LAS float* wp = wg + (((j * 4 + e) * 64 + lane) << 3); const f32x4 w0 = *(const LAS f32x4*)wp, w1 = *(const LAS f32x4*)(wp + 4);
                ga[0] += y[e] * w0[0]; ga[1] += y[e] * w0[1]; ga[2] += y[e] * w0[2]; ga[3] += y[e] * w0[3];
                ga[4] += y[e] * w1[0]; ga[5] += y[e] * w1[1]; ga[6] += y[e] * w1[2]; ga[7] += y[e] * w1[3]; }
            __builtin_amdgcn_sched_barrier(0); }
    }
    if (GATES) {
#pragma unroll
        for (int e = 0; e < 8; ++e) ga[e] = wave_sum(ga[e]);
        if (lane < 8) { float x = ga[0];
#pragma unroll
            for (int e = 1; e < 8; ++e) x = (lane == e) ? ga[e] : x;
            x += gbias[lane];
            if (lane >= 4) x = fminf(x, 0.f) - log1pf(expf(-fabsf(x)));
            GA[(size_t)row * 8 + lane] = x; }
    }
}
__device__ __forceinline__ void ld_xh(f32x4 (&v)[4], const unsigned short* xrow, int lane) {
#pragma unroll
    for (int j = 0; j < 4; ++j) { const u32x2 w = *(const u32x2*)(xrow + j * 256 + lane * 4); v[j] = (f32x4){bflo(w.x), bfhi(w.x), bflo(w.y), bfhi(w.y)}; }
}
__device__ __forceinline__ void fix_row(f32x4 (&v)[4], int row, const float* xs, unsigned short* xh, const float* fx_slab, int fx_npart, bool base_f32, const float* fx_gate, float fx_s, float* outf, int lane) {
    const int r = row - MP;
    if (fx_npart == 0) {
#pragma unroll
        for (int j = 0; j < 4; ++j) v[j] = *(const f32x4*)(xs + (size_t)r * D + j * 256 + lane * 4);
        return; }
    const float* gp = fx_gate + (size_t)bidx(row) * NADA;
    f32x4 bs[4];
    if (base_f32) {
#pragma unroll
        for (int j = 0; j < 4; ++j) bs[j] = *(const f32x4*)(xs + (size_t)r * D + j * 256 + lane * 4); }
    else ld_xh(bs, xh + (size_t)row * D, lane);
#pragma unroll
    for (int j = 0; j < 4; ++j) { const int col = j * 256 + lane * 4; f32x4 pv[11];
#pragma unroll
        for (int p = 0; p < 11; ++p) { const int pc = p < fx_npart ? p : 0; pv[p] = *(const f32x4*)(fx_slab + ((size_t)pc * 512 + r) * 1024 + col); }
        f32x4 a = {0.f, 0.f, 0.f, 0.f};
#pragma unroll
        for (int p = 0; p < 11; ++p) a = a + pv[p] * (p < fx_npart ? 1.0f : 0.0f);
        v[j] = bs[j] + (*(const f32x4*)(gp + col) * fx_s) * a;
        if (outf) *(f32x4*)(outf + (size_t)row * D + col) = v[j];
        else { u32x2 o; o.x = pk2(v[j][0], v[j][1]); o.y = pk2(v[j][2], v[j][3]); *(u32x2*)(xh + (size_t)row * D + col) = o;
            v[j] = (f32x4){bflo(o.x), bfhi(o.x), bflo(o.y), bfhi(o.y)}; } }
}
template <bool GATES>
__device__ __forceinline__ void norm_phase(const float* xp, const float* xs, unsigned short* xh, bool x_f32, const float* nw, const float* adaL, int j3, unsigned short* XN,
                                           const float* wg_src  , const float* gbias, float* GA, LAS float* wg, const float* fx_slab, int fx_npart, bool fx_base_f32, const float* fx_gate, float fx_s, bool probe_pass, const float* adap  , const float* adab, float* ada_out, int gw_, int NGW_, int lane_, int tid_) {
    if (GATES) {
        { float wv[16];
#pragma unroll
          for (int k = 0; k < 16; ++k) { const int i = tid_ + 512 * k, c = i >> 3; wv[k] = wg_src[(size_t)c * 3592 + 2048 + (i & 7)]; }
#pragma unroll
          for (int k = 0; k < 16; ++k) { const int i = tid_ + 512 * k, c = i >> 3; wg[((((c >> 8) * 4 + (c & 3)) * 64 + ((c >> 2) & 63)) << 3) + (i & 7)] = wv[k]; } }
        __syncthreads();
    }
    if (adap) {
        for (int i = (gw_ / NWAVES) * 512 + tid_; i < 2 * NBR * NADA / 4; i += (NGW_ / NWAVES) * 512) { const int e = i * 4, l = e / (NBR * NADA), n = e % NADA;
            f32x4 s = *(const f32x4*)(adab + (size_t)l * NADA + n);
#pragma unroll
            for (int ks = 0; ks < NKS; ++ks) s = s + *(const f32x4*)(adap + (size_t)ks * 2 * NBR * NADA + e);
            *(f32x4*)(ada_out + e) = s; } }
    f32x4 v[4];
    LAS float* pl = wg + 8192;
    const int vcu_ = gw_ / NWAVES, wv_ = gw_ % NWAVES, G_ = NGW_ / NWAVES;
    const bool sq = !adap && !probe_pass && G_ == 256;
    const int srow = 2 * vcu_ + (wv_ >> 2), scol = 256 * (wv_ & 3) + 4 * lane_, sb = 8 + (srow >> 4);
    f32x4 q_part[11], q_gate, q_nw, q_sc, q_sh, q_basef; u32x2 q_baseh;
    if (sq) {
#pragma unroll
        for (int p = 0; p < 11; ++p) { const int pc = p < fx_npart ? p : 0; q_part[p] = *(const f32x4*)(fx_slab + ((size_t)pc * 512 + srow) * 1024 + scol); }
        q_gate = *(const f32x4*)(fx_gate + (size_t)sb * NADA + scol); q_nw = *(const f32x4*)(nw + scol);
        q_sh = *(const f32x4*)(adaL + (size_t)sb * NADA + j3 * 1024 + scol); q_sc = *(const f32x4*)(adaL + (size_t)sb * NADA + j3 * 1024 + 1024 + scol);
        q_basef = *(const f32x4*)(xs + (size_t)srow * D + scol);
        q_baseh = *(const u32x2*)(xh + (size_t)(MP + srow) * D + scol); }
    for (int bl = vcu_; bl < MP / 64 + (adap ? 32 : 0); bl += G_) {
        const bool sblk = bl >= MP / 64;
        const int b = sblk ? 8 + (bl - MP / 64) : bl >> 5; const float* sh = adaL + (size_t)b * NADA + j3 * 1024; const float* sc = sh + 1024;
        __syncthreads();
        for (int i = tid_; i < 256; i += 512) { const f32x4 g4 = *(const f32x4*)(nw + 4 * i); f32x4 s14, s04;
            if (adap) { const size_t o = (size_t)b * NADA + j3 * 1024 + 4 * i; s04 = *(const f32x4*)(adab + j3 * 1024 + 4 * i); s14 = *(const f32x4*)(adab + j3 * 1024 + 1024 + 4 * i);
#pragma unroll
                for (int ks = 0; ks < NKS; ++ks) { s04 = s04 + *(const f32x4*)(adap + (size_t)ks * 2 * NBR * NADA + o); s14 = s14 + *(const f32x4*)(adap + (size_t)ks * 2 * NBR * NADA + o + 1024); } }
            else { s14 = *(const f32x4*)(sc + 4 * i); s04 = *(const f32x4*)(sh + 4 * i); }
            *(LAS f32x4*)(pl + 4 * i) = g4 * (s14 + 1.0f); *(LAS f32x4*)(pl + 1024 + 4 * i) = s04; }
        __syncthreads();
        if (sblk) {
            for (int r = 0; r < 2; ++r) { const int row = MP + 16 * (bl - MP / 64) + 2 * wv_ + r;
#pragma unroll
                for (int j = 0; j < 4; ++j) v[j] = *(const f32x4*)(xs + (size_t)(row - MP) * D + j * 256 + lane_ * 4);
                norm_row<GATES, true>(v, row, nw, adaL, j3, XN, gbias, GA, wg, pl, lane_); }
            continue; }
        const int rb = 64 * bl + 8 * wv_;
        if (x_f32) {
            f32x4 vn[4];
#pragma unroll
            for (int j = 0; j < 4; ++j) vn[j] = *(const f32x4*)(xp + (size_t)rb * D + j * 256 + lane_ * 4);
            for (int r = 0; r < 8; ++r) {
#pragma unroll
                for (int j = 0; j < 4; ++j) v[j] = vn[j];
                const int rn = rb + (r < 7 ? r + 1 : r);
#pragma unroll
                for (int j = 0; j < 4; ++j) vn[j] = *(const f32x4*)(xp + (size_t)rn * D + j * 256 + lane_ * 4);
                norm_row<GATES, true>(v, rb + r, nw, adaL, j3, XN, gbias, GA, wg, pl, lane_); }
        } else {
            u32x2 wn[4];
#pragma unroll
            for (int j = 0; j < 4; ++j) wn[j] = *(const u32x2*)(xh + (size_t)rb * D + j * 256 + lane_ * 4);
            for (int r = 0; r < 8; ++r) {
#pragma unroll
                for (int j = 0; j < 4; ++j) v[j] = (f32x4){bflo(wn[j].x), bfhi(wn[j].x), bflo(wn[j].y), bfhi(wn[j].y)};
                const int rn = rb + (r < 7 ? r + 1 : r);
#pragma unroll
                for (int j = 0; j < 4; ++j) wn[j] = *(const u32x2*)(xh + (size_t)rn * D + j * 256 + lane_ * 4);
                norm_row<GATES, true>(v, rb + r, nw, adaL, j3, XN, gbias, GA, wg, pl, lane_); }
        }
    }
    if (sq) {
        LAS float* red = pl + 2048;
        f32x4 a = {0.f, 0.f, 0.f, 0.f};
#pragma unroll
        for (int p = 0; p < 11; ++p) a = a + q_part[p] * (p < fx_npart ? 1.0f : 0.0f);
        const f32x4 bs = fx_base_f32 ? q_basef : (f32x4){bflo(q_baseh.x), bfhi(q_baseh.x), bflo(q_baseh.y), bfhi(q_baseh.y)};
        f32x4 xv = bs + (q_gate * fx_s) * a;
        { u32x2 o; o.x = pk2(xv[0], xv[1]); o.y = pk2(xv[2], xv[3]); *(u32x2*)(xh + (size_t)(MP + srow) * D + scol) = o; xv = (f32x4){bflo(o.x), bfhi(o.x), bflo(o.y), bfhi(o.y)}; }
        const float ssq = wave_sum((xv[0] * xv[0] + xv[1] * xv[1]) + (xv[2] * xv[2] + xv[3] * xv[3]));
        __syncthreads();
        if (lane_ == 0) red[wv_] = ssq;
        __syncthreads();
        const int w0 = wv_ & 4; const float rstd = 1.0f / sqrtf(((red[w0] + red[w0 + 1]) + (red[w0 + 2] + red[w0 + 3])) * (1.0f / D) + EPS);
        const f32x4 y = xv * rstd * q_nw * (q_sc + 1.0f) + q_sh;
        { u32x2 o; o.x = pk2(y[0], y[1]); o.y = pk2(y[2], y[3]); *(u32x2*)(XN + (size_t)(MP + srow) * D + scol) = o; }
        if (GATES) { float ga[8];
#pragma unroll
            for (int e = 0; e < 8; ++e) ga[e] = 0.f;
#pragma unroll
            for (int c = 0; c < 4; ++c) { const LAS float* wp = wg + ((((wv_ & 3) * 4 + c) * 64 + lane_) << 3); const f32x4 w0v = *(const LAS f32x4*)wp, w1v = *(const LAS f32x4*)(wp + 4);
                ga[0] += y[c] * w0v[0]; ga[1] += y[c] * w0v[1]; ga[2] += y[c] * w0v[2]; ga[3] += y[c] * w0v[3]; ga[4] += y[c] * w1v[0]; ga[5] += y[c] * w1v[1]; ga[6] += y[c] * w1v[2]; ga[7] += y[c] * w1v[3]; }
#pragma unroll
            for (int e = 0; e < 8; ++e) ga[e] = wave_sum(ga[e]);
            __syncthreads();
            if (lane_ < 8) { float x = ga[0];
#pragma unroll
                for (int e = 1; e < 8; ++e) x = (lane_ == e) ? ga[e] : x;
                red[8 + wv_ * 8 + lane_] = x; }
            __syncthreads();
            if ((wv_ & 3) == 0 && lane_ < 8) { float x = (red[8 + wv_ * 8 + lane_] + red[8 + (wv_ + 1) * 8 + lane_]) + (red[8 + (wv_ + 2) * 8 + lane_] + red[8 + (wv_ + 3) * 8 + lane_]) + gbias[lane_];
                if (lane_ >= 4) x = fminf(x, 0.f) - log1pf(expf(-fabsf(x)));
                GA[(size_t)(MP + srow) * 8 + lane_] = x; } }
    }
    else if (!probe_pass && !adap) for (int row = MP + gw_; row < MT; row += NGW_) { fix_row(v, row, xs, xh, fx_slab, fx_npart, fx_base_f32, fx_gate, fx_s, nullptr, lane_); norm_row<GATES, false>(v, row, nw, adaL, j3, XN, gbias, GA, wg, nullptr, lane_); }
}

__device__ __forceinline__ void bias_wg(const unsigned short* WT, const float* shb, float* bias, LAS unsigned char* lds, int wgi, int nwg, int tid, int npairs = 176, int ldb = 5632) {
    const int lane = tid & 63, w = __builtin_amdgcn_readfirstlane(tid >> 6), li = lane & 15, q = lane >> 4;
    if (wgi >= npairs) return;
    LAS unsigned short* shs = (LAS unsigned short*)lds; LAS float* scr = (LAS float*)(lds + 99072);
    LDS_BARRIER();
    { f32x4 v[20];
#pragma unroll
      for (int j = 0; j < 20; ++j) { const int i = tid + 512 * j; v[j] = *(const f32x4*)(shb + (size_t)(i >> 8) * NADA + 4 * (i & 255)); }
#pragma unroll
      for (int j = 0; j < 20; ++j) { const int i = tid + 512 * j; u32x2 o; o.x = pk2(v[j][0], v[j][1]); o.y = pk2(v[j][2], v[j][3]); *(LAS u32x2*)(shs + (i >> 8) * 1032 + 4 * (i & 255)) = o; } }
    LDS_BARRIER();
    for (int pair = wgi; pair < npairs; pair += nwg) {
        const int n0 = 16 * (2 * pair + (w >> 2)), kq = w & 3;
        bf16x8 a[8];
#pragma unroll
        for (int ks = 0; ks < 8; ++ks) a[ks] = *(const bf16x8*)(WT + (size_t)(n0 + li) * 1024 + 256 * kq + 32 * ks + 8 * q);
        f32x4 acc[3];
#pragma unroll
        for (int bt = 0; bt < 3; ++bt) acc[bt] = (f32x4){0.f, 0.f, 0.f, 0.f};
#pragma unroll
        for (int ks = 0; ks < 8; ++ks)
#pragma unroll
            for (int bt = 0; bt < 3; ++bt) acc[bt] = mfma16(a[ks], *(const LAS bf16x8*)(shs + (16 * bt + li) * 1032 + 256 * kq + 32 * ks + 8 * q), acc[bt]);
        LDS_BARRIER();
#pragma unroll
        for (int bt = 0; bt < 3; ++bt) *(LAS f32x4*)(scr + ((w * 3 + bt) * 64 + lane) * 4) = acc[bt];
        LDS_BARRIER();
        if (kq == 0) {
#pragma unroll
            for (int bt = 0; bt < 3; ++bt) { f32x4 t = *(const LAS f32x4*)(scr + ((w * 3 + bt) * 64 + lane) * 4);
#pragma unroll
                for (int j = 1; j < 4; ++j) t = t + *(const LAS f32x4*)(scr + (((w + j) * 3 + bt) * 64 + lane) * 4);
                const int b = 16 * bt + li;
                if (b < NBR) *(f32x4*)(bias + (size_t)b * ldb + n0 + 4 * q) = t; } }
    }
}
__device__ __forceinline__ void sample_fold(unsigned short* xh, const float* slab, int npart, const float* gate, float fs, const float* nw, const float* adaL, int j3, unsigned short* XS, LAS float* red, unsigned* ctr, int li, int nl, int tid) {
    const int lane = tid & 63, wv = __builtin_amdgcn_readfirstlane(tid >> 6);
    const int scol = 256 * (wv & 3) + 4 * lane;
    f32x4 part[11], g4, sh4, sc4; u32x2 bh;
#define SF_LOAD(rp_) do { const int rpc_ = (rp_) < 256 ? (rp_) : 255, sr_ = 2 * rpc_ + (wv >> 2), sb_ = 8 + (sr_ >> 4); \
        _Pragma("unroll") for (int p = 0; p < 11; ++p) { const int pc = p < npart ? p : 0; part[p] = *(const f32x4*)(slab + ((size_t)pc * 512 + sr_) * 1024 + scol); } \
        g4 = *(const f32x4*)(gate + (size_t)sb_ * NADA + scol); sh4 = *(const f32x4*)(adaL + (size_t)sb_ * NADA + j3 * 1024 + scol); sc4 = *(const f32x4*)(adaL + (size_t)sb_ * NADA + j3 * 1024 + 1024 + scol); \
        bh = *(const u32x2*)(xh + (size_t)(MP + sr_) * D + scol); } while (0)
    const f32x4 n4 = *(const f32x4*)(nw + scol);
    SF_LOAD(li);
    for (int rp = li; rp < 256; rp += nl) {
        const int srow = 2 * rp + (wv >> 2);
        f32x4 a = {0.f, 0.f, 0.f, 0.f};
#pragma unroll
        for (int p = 0; p < 11; ++p) a = a + part[p] * (p < npart ? 1.0f : 0.0f);
        f32x4 xv = (f32x4){bflo(bh.x), bfhi(bh.x), bflo(bh.y), bfhi(bh.y)} + (g4 * fs) * a;
        const f32x4 mul4 = n4 * (sc4 + 1.0f), add4 = sh4;
        SF_LOAD(rp + nl);
        { u32x2 o; o.x = pk2(xv[0], xv[1]); o.y = pk2(xv[2], xv[3]); __hip_atomic_store((unsigned long long*)(xh + (size_t)(MP + srow) * D + scol), ((unsigned long long)o.y << 32) | o.x, __ATOMIC_RELAXED, __HIP_MEMORY_SCOPE_AGENT);
          xv = (f32x4){bflo(o.x), bfhi(o.x), bflo(o.y), bfhi(o.y)}; }
        const float ssq = wave_sum((xv[0] * xv[0] + xv[1] * xv[1]) + (xv[2] * xv[2] + xv[3] * xv[3]));
        LDS_BARRIER();
        if (lane == 0) red[wv] = ssq;
        LDS_BARRIER();
        const int w0 = wv & 4; const float rstd = 1.0f / sqrtf(((red[w0] + red[w0 + 1]) + (red[w0 + 2] + red[w0 + 3])) * (1.0f / D) + EPS);
        const f32x4 y = xv * rstd * mul4 + add4;
        { u32x2 o; o.x = pk2(y[0], y[1]); o.y = pk2(y[2], y[3]); __hip_atomic_store((unsigned long long*)(XS + (size_t)(MP + srow) * D + scol), ((unsigned long long)o.y << 32) | o.x, __ATOMIC_RELAXED, __HIP_MEMORY_SCOPE_AGENT); }
    }
#undef SF_LOAD
    VM_WAIT();
    __syncthreads();
    if (tid == 0) (void)__hip_atomic_fetch_add(ctr, 1u, __ATOMIC_RELAXED, __HIP_MEMORY_SCOPE_AGENT);
}

constexpr int ML_Q = 0, ML_K = 17408, ML_V = 34816, ML_KW = 53248, ML_S = 71680, ML_CT = 80896, ML_TAB = 115712;
constexpr int MLP = 136, MLV = 144, MSP = 72;

__device__ __forceinline__ void mlstm_seq(LAS unsigned char* lds, const unsigned short* QA, const unsigned short* KA, const unsigned short* VA, const unsigned short* OA, const float* GA,
                                          unsigned short* MIX, const float* gnorm, int rowbase, int h, int nchunk, int cfull0  , int L,
                                          const float* C0, const float* n0, const float* m0p, float* Cout, float* nout, float* mout, int tid) {
    const int lane = tid & 63, w = __builtin_amdgcn_readfirstlane(tid >> 6), li = lane & 15, q = lane >> 4, qq = li >> 2, pp = li & 3;
    LAS unsigned short* Qs = (LAS unsigned short*)(lds + ML_Q); LAS unsigned short* Ks = (LAS unsigned short*)(lds + ML_K);
    LAS unsigned short* Vs = (LAS unsigned short*)(lds + ML_V); LAS unsigned short* Kws = (LAS unsigned short*)(lds + ML_KW);
    LAS unsigned short* Ss = (LAS unsigned short*)(lds + ML_S); LAS unsigned short* CT = (LAS unsigned short*)(lds + ML_CT);
    LAS float* nS = (LAS float*)(lds + ML_TAB); LAS float* qnS = nS + 128; LAS float* SpS = qnS + 64; LAS float* ssS = SpS + 256;
    LDS_BARRIER();
    f32x4 accC[8];
    if (C0) {
#pragma unroll
        for (int i = 0; i < 8; ++i)
#pragma unroll
            for (int r = 0; r < 4; ++r) accC[i][r] = C0[(size_t)(16 * i + 4 * q + r) * 128 + 16 * w + li];
    } else {
#pragma unroll
        for (int i = 0; i < 8; ++i) accC[i] = (f32x4){0.f, 0.f, 0.f, 0.f}; }
#pragma unroll
    for (int i = 0; i < 8; ++i) {
        u32x2 o; o.x = pk2(accC[i][0], accC[i][1]); o.y = pk2(accC[i][2], accC[i][3]);
        *(LAS u32x2*)(CT + (16 * w + li) * MLP + 16 * i + 4 * q) = o; }
    float m = m0p ? *m0p : 0.f;
    if (tid < 128) nS[tid] = n0 ? n0[tid] : 0.f;
    v4u pq[2], pk[2], pv[2];
    const v4u zero4 = {0u, 0u, 0u, 0u};
#pragma unroll
    for (int c2 = 0; c2 < 2; ++c2) { const int ci = tid + 512 * c2, r = ci >> 4, c16 = ci & 15; const size_t off = (size_t)(rowbase + r) * 512 + h * 128 + 8 * c16;
        if (r < L) { pq[c2] = *(const v4u*)(QA + off); pk[c2] = *(const v4u*)(KA + off); pv[c2] = *(const v4u*)(VA + off); } else { pq[c2] = zero4; pk[c2] = zero4; pv[c2] = zero4; } }
    const bool valid = lane < L; const int lcl = valid ? lane : L - 1;
    float ign = GA[(size_t)(rowbase + lcl) * 8 + h], lfn = GA[(size_t)(rowbase + lcl) * 8 + 4 + h];
    for (int ch = 0; ch < nchunk; ++ch) {
        const int row0 = rowbase + ch * 64;
        u32x2 ovp[4];
#pragma unroll
        for (int lt = 0; lt < 4; ++lt) { const int l = 16 * lt + li, lc = l < L ? l : L - 1; ovp[lt] = *(const u32x2*)(OA + (size_t)(row0 + lc) * 512 + h * 128 + 16 * w + 4 * q); }
        const float ig = valid ? ign : -1e30f, lf = valid ? lfn : 0.f;
        const float bcs = scan_add(lf), blast = rdlane(bcs, 63);
        const float av = ig - bcs;
        const float Mv = fmaxf(m, scan_max(av));
        const float iw = __expf(m - Mv), emt = __expf(-(bcs + Mv));
        const float gv = blast + av, mnew = fmaxf(blast + m, wave_max(gv));
        const float wprev = __expf(blast + m - mnew), wsv = __expf(gv - mnew);
        LDS_BARRIER();
#pragma unroll
        for (int c2 = 0; c2 < 2; ++c2) { const int ci = tid + 512 * c2, r = ci >> 4, c16 = ci & 15; const int lo = r * MLP + 8 * c16;
            const int lov = r * MLV + 8 * c16;
            *(LAS v4u*)(Vs + lov) = pv[c2];
            const float sc = bperm(wsv, r) * 0.08838834764831845f; v4u kw;
            kw.x = pk2(bflo(pk[c2].x) * sc, bfhi(pk[c2].x) * sc); kw.y = pk2(bflo(pk[c2].y) * sc, bfhi(pk[c2].y) * sc);
            kw.z = pk2(bflo(pk[c2].z) * sc, bfhi(pk[c2].z) * sc); kw.w = pk2(bflo(pk[c2].w) * sc, bfhi(pk[c2].w) * sc);
            *(LAS v4u*)(Kws + lov) = kw; }
        if (ch >= cfull0) {
#pragma unroll
            for (int c2 = 0; c2 < 2; ++c2) { const int ci = tid + 512 * c2, r = ci >> 4, c16 = ci & 15; *(LAS v4u*)(Qs + r * MLP + 8 * c16) = pq[c2]; *(LAS v4u*)(Ks + r * MLP + 8 * c16) = pk[c2]; } }
        if (ch + 1 < nchunk && ch + 1 >= cfull0) {
#pragma unroll
            for (int c2 = 0; c2 < 2; ++c2) { const int ci = tid + 512 * c2, r = ci >> 4, c16 = ci & 15; pq[c2] = *(const v4u*)(QA + (size_t)(row0 + 64 + r) * 512 + h * 128 + 8 * c16); } }
        if (ch + 1 < nchunk) {
#pragma unroll
            for (int c2 = 0; c2 < 2; ++c2) { const int ci = tid + 512 * c2, r = ci >> 4, c16 = ci & 15; const size_t off = (size_t)(row0 + 64 + r) * 512 + h * 128 + 8 * c16;
                pk[c2] = *(const v4u*)(KA + off); pv[c2] = *(const v4u*)(VA + off); }
            ign = GA[(size_t)(row0 + 64 + lcl) * 8 + h]; lfn = GA[(size_t)(row0 + 64 + lcl) * 8 + 4 + h]; }
        LDS_BARRIER();
        bf16x8 vf[2];
        if (ch >= cfull0) {
        { const int st = w >> 1, lt0 = 2 * (w & 1);
          f32x4 sacc[2] = {{0.f, 0.f, 0.f, 0.f}, {0.f, 0.f, 0.f, 0.f}};
#pragma unroll
          for (int ks = 0; ks < 4; ++ks) { const bf16x8 a = *(const LAS bf16x8*)(Ks + (16 * st + li) * MLP + 32 * ks + 8 * q);
#pragma unroll
              for (int t2 = 0; t2 < 2; ++t2) { const bf16x8 bq = *(const LAS bf16x8*)(Qs + (16 * (lt0 + t2) + li) * MLP + 32 * ks + 8 * q); sacc[t2] = mfma16(a, bq, sacc[t2]); } }
          float a4[4];
#pragma unroll
          for (int r = 0; r < 4; ++r) a4[r] = bperm(av, 16 * st + 4 * q + r);
#pragma unroll
          for (int t2 = 0; t2 < 2; ++t2) { const int l = 16 * (lt0 + t2) + li; const float Ml = bperm(Mv, l); float vals[4], ps = 0.f;
#pragma unroll
              for (int r = 0; r < 4; ++r) { const int s = 16 * st + 4 * q + r; vals[r] = sacc[t2][r] * ((s <= l) ? 0.08838834764831845f : 0.f) * __expf(fminf(a4[r] - Ml, 0.f)); ps += vals[r]; }
              ps = qsum(ps);
              if (q == 0) SpS[st * 64 + l] = ps;
              u32x2 o; o.x = pk2(vals[0], vals[1]); o.y = pk2(vals[2], vals[3]);
              *(LAS u32x2*)(Ss + l * MSP + 16 * st + 4 * q) = o; }
          { const int l = tid >> 3, part = tid & 7; const LAS unsigned* qp = (const LAS unsigned*)(Qs + l * MLP + 16 * part); const LAS float* np = nS + 16 * part; float s = 0.f;
#pragma unroll
            for (int e = 0; e < 8; ++e) { const unsigned wq = qp[e]; s += bflo(wq) * np[2 * e] + bfhi(wq) * np[2 * e + 1]; }
            s = rsum8(s);
            if (part == 0) qnS[l] = s; } }
        LDS_BARRIER();
        { f32x4 nacc[4];
#pragma unroll
          for (int lt = 0; lt < 4; ++lt) nacc[lt] = (f32x4){0.f, 0.f, 0.f, 0.f};
#pragma unroll
          for (int ks = 0; ks < 4; ++ks) { const bf16x8 a = *(const LAS bf16x8*)(CT + (16 * w + li) * MLP + 32 * ks + 8 * q);
#pragma unroll
              for (int lt = 0; lt < 4; ++lt) { const bf16x8 bq = *(const LAS bf16x8*)(Qs + (16 * lt + li) * MLP + 32 * ks + 8 * q); nacc[lt] = mfma16(a, bq, nacc[lt]); } }
#pragma unroll
          for (int lt = 0; lt < 4; ++lt) { const float iwl = bperm(iw, 16 * lt + li); nacc[lt] = nacc[lt] * iwl; }
#pragma unroll
          for (int k2 = 0; k2 < 2; ++k2) { const LAS unsigned short* vp = Vs + (32 * k2 + 8 * q + qq) * MLV + 16 * w + 4 * pp;
              vf[k2] = cat8(ldtr(vp), ldtr(vp + 4 * MLV));
#pragma unroll
              for (int lt = 0; lt < 4; ++lt) { const bf16x8 bs = *(const LAS bf16x8*)(Ss + (16 * lt + li) * MSP + 32 * k2 + 8 * q); nacc[lt] = mfma16(vf[k2], bs, nacc[lt]); } }
          const float den = iw * qnS[lane] + ((SpS[lane] + SpS[64 + lane]) + (SpS[128 + lane] + SpS[192 + lane]));
          const float rs = __builtin_amdgcn_rcpf(fmaxf(fabsf(den), emt));
#pragma unroll
          for (int lt = 0; lt < 4; ++lt) { const int l = 16 * lt + li; const float rsl = bperm(rs, l); nacc[lt] = nacc[lt] * rsl;
              float ss = (nacc[lt][0] * nacc[lt][0] + nacc[lt][1] * nacc[lt][1]) + (nacc[lt][2] * nacc[lt][2] + nacc[lt][3] * nacc[lt][3]);
              ss = qsum(ss);
              if (q == 0) ssS[w * 64 + l] = ss; }
          LDS_BARRIER();
          float tot = 0.f;
#pragma unroll
          for (int w2 = 0; w2 < 8; ++w2) tot += ssS[w2 * 64 + lane];
          const float rstd = __builtin_amdgcn_rsqf(tot * (1.0f / 128.0f) + EPS);
          const f32x4 gn = *(const f32x4*)(gnorm + 16 * w + 4 * q);
#pragma unroll
          for (int lt = 0; lt < 4; ++lt) { const int l = 16 * lt + li; const float rl = bperm(rstd, l);
              if (l < L) { const size_t row = (size_t)(row0 + l); const u32x2 ov = ovp[lt];
                  const float o0 = nacc[lt][0] * rl * gn[0] * fast_sigmoid(bflo(ov.x)), o1 = nacc[lt][1] * rl * gn[1] * fast_sigmoid(bfhi(ov.x));
                  const float o2 = nacc[lt][2] * rl * gn[2] * fast_sigmoid(bflo(ov.y)), o3 = nacc[lt][3] * rl * gn[3] * fast_sigmoid(bfhi(ov.y));
                  u32x2 o; o.x = pk2(o0, o1); o.y = pk2(o2, o3);
                  *(u32x2*)(MIX + row * 1024 + h * 128 + 16 * w + 4 * q) = o; } } }
        } else {
#pragma unroll
            for (int k2 = 0; k2 < 2; ++k2) { const LAS unsigned short* vp = Vs + (32 * k2 + 8 * q + qq) * MLV + 16 * w + 4 * pp; vf[k2] = cat8(ldtr(vp), ldtr(vp + 4 * MLV)); } }
        f32x4 nsum = {0.f, 0.f, 0.f, 0.f}; const bf16x8 ones8 = {0x3f80, 0x3f80, 0x3f80, 0x3f80, 0x3f80, 0x3f80, 0x3f80, 0x3f80};
#pragma unroll
        for (int i = 0; i < 8; ++i) accC[i] = accC[i] * wprev;
#pragma unroll
        for (int k2 = 0; k2 < 2; ++k2) {
#pragma unroll
            for (int i = 0; i < 8; ++i) { const LAS unsigned short* kp = Kws + (32 * k2 + 8 * q + qq) * MLV + 16 * i + 4 * pp;
                const bf16x8 a = cat8(ldtr(kp), ldtr(kp + 4 * MLV)); accC[i] = mfma16(a, vf[k2], accC[i]);
                if (i == w) nsum = mfma16(a, ones8, nsum); } }
        if (ch + 1 >= cfull0) {
#pragma unroll
        for (int i = 0; i < 8; ++i) { u32x2 o; o.x = pk2(accC[i][0], accC[i][1]); o.y = pk2(accC[i][2], accC[i][3]); *(LAS u32x2*)(CT + (16 * w + li) * MLP + 16 * i + 4 * q) = o; } }
        if (li == 0) {
#pragma unroll
            for (int r = 0; r < 4; ++r) nS[16 * w + 4 * q + r] = wprev * nS[16 * w + 4 * q + r] + nsum[r]; }
        m = mnew;
    }
    if (Cout) {
#pragma unroll
    for (int i = 0; i < 8; ++i)
#pragma unroll
        for (int r = 0; r < 4; ++r) Cout[(size_t)(16 * i + 4 * q + r) * 128 + 16 * w + li] = accC[i][r]; }
    LDS_BARRIER();
    if (Cout) { if (tid < 128) nout[tid] = nS[tid];
        if (tid == 0) *mout = m; }
}

constexpr int AT_P = 72;
template <int NKT, int MODE>
__device__ __forceinline__ void attn_block(f32x4 (&accO)[4], float& mrun, float& lrun, const LAS unsigned short* Kt, const LAS unsigned short* Vt, const bf16x8 (&qf)[2],
                                           int rel0, const LAS float* tbl, int nvalid, int li, int q) {
    const int qq = li >> 2, pp = li & 3;
    constexpr float SC = 0.125f * 1.4426950408889634f;
    const LAS unsigned short* kb = Kt + li * AT_P + 8 * q;
    const LAS unsigned short* vb = Vt + (4 * q + qq) * AT_P + 4 * pp;
    f32x4 s[NKT];
#pragma unroll
    for (int kt = 0; kt < NKT; ++kt) { s[kt] = (f32x4){0.f, 0.f, 0.f, 0.f};
#pragma unroll
        for (int ks = 0; ks < 2; ++ks) { const bf16x8 a = *(const LAS bf16x8*)(kb + 16 * kt * AT_P + 32 * ks); s[kt] = mfma16(a, qf[ks], s[kt]); } }
    float mx = -1e30f;
    if (MODE == 0) { const float b0 = tbl[0];
#pragma unroll
        for (int kt = 0; kt < NKT; ++kt)
#pragma unroll
            for (int r = 0; r < 4; ++r) { s[kt][r] = s[kt][r] * SC + b0; mx = fmaxf(mx, s[kt][r]); }
    } else if (MODE == 1) { const LAS float* tb = tbl + (rel0 + 4 * q + 128);
#pragma unroll
        for (int kt = 0; kt < NKT; ++kt)
#pragma unroll
            for (int r = 0; r < 4; ++r) { s[kt][r] = s[kt][r] * SC + tb[16 * kt + r]; mx = fmaxf(mx, s[kt][r]); }
    } else {
#pragma unroll
        for (int kt = 0; kt < NKT; ++kt)
#pragma unroll
            for (int r = 0; r < 4; ++r) { const int key = 16 * kt + 4 * q + r; int rel = rel0 + key; rel = rel < -128 ? -128 : (rel > 128 ? 128 : rel);
                float v = s[kt][r] * SC + tbl[rel + 128]; if (MODE == 3) v = key < nvalid ? v : -1e30f; s[kt][r] = v; mx = fmaxf(mx, v); }
    }
    mx = qmax(mx);
    if (__any(mx > mrun)) {
        const float mnew = fmaxf(mrun, mx), alpha = __builtin_amdgcn_exp2f(mrun - mnew); mrun = mnew; lrun *= alpha;
#pragma unroll
        for (int dt = 0; dt < 4; ++dt) accO[dt] = accO[dt] * alpha; }
    float ps = 0.f;
#pragma unroll
    for (int kt = 0; kt < NKT; ++kt)
#pragma unroll
        for (int r = 0; r < 4; ++r) { const float p = __builtin_amdgcn_exp2f(s[kt][r] - mrun); s[kt][r] = p; ps += p; }
    lrun += ps;
#pragma unroll
    for (int k2 = 0; k2 < NKT / 2; ++k2) {
        v4u pw; pw.x = pk2(s[2 * k2][0], s[2 * k2][1]); pw.y = pk2(s[2 * k2][2], s[2 * k2][3]); pw.z = pk2(s[2 * k2 + 1][0], s[2 * k2 + 1][1]); pw.w = pk2(s[2 * k2 + 1][2], s[2 * k2 + 1][3]);
        const bf16x8 pb = __builtin_bit_cast(bf16x8, pw);
#pragma unroll
        for (int dt = 0; dt < 4; ++dt) { const LAS unsigned short* vp = vb + 32 * k2 * AT_P + 16 * dt;
            const bf16x8 a = cat8(ldtr(vp), ldtr(vp + 16 * AT_P)); accO[dt] = mfma16(a, pb, accO[dt]); } }
}
__device__ __forceinline__ void attn_store(const f32x4 (&accO)[4], float lrun, unsigned short* dst  , int q) {
    lrun = qsum(lrun);
    const float inv = __builtin_amdgcn_rcpf(lrun);
#pragma unroll
    for (int dt = 0; dt < 4; ++dt) { u32x2 o; o.x = pk2(accO[dt][0] * inv, accO[dt][1] * inv); o.y = pk2(accO[dt][2] * inv, accO[dt][3] * inv); *(u32x2*)(dst + 16 * dt + 4 * q) = o; }
}
constexpr int AT_TBL = 120832, AT_BUF = 0;
__device__ __forceinline__ void band_prompt_unit(LAS unsigned char* lds, const unsigned short* QB, const unsigned short* KB, const unsigned short* VB, unsigned short* MIX, int b, int c, int hp, int tid) {
    const int lane = tid & 63, w = __builtin_amdgcn_readfirstlane(tid >> 6), li = lane & 15, q = lane >> 4, hl = w >> 2, head = 2 * hp + hl, qoff = 16 * (w & 3) + li;
    const LAS float* tbl = (const LAS float*)(lds + AT_TBL) + head * 264;
    constexpr int BUFE = 2 * 64 * AT_P;
    LAS unsigned short* Kbuf = (LAS unsigned short*)(lds + AT_BUF); LAS unsigned short* Vbuf = Kbuf + 2 * BUFE;
    const size_t qrow = (size_t)b * 2048 + c * 64 + qoff;
    bf16x8 qf[2];
#pragma unroll
    for (int ks = 0; ks < 2; ++ks) qf[ks] = *(const bf16x8*)(QB + qrow * 512 + head * 64 + 32 * ks + 8 * q);
    f32x4 accO[4];
#pragma unroll
    for (int dt = 0; dt < 4; ++dt) accO[dt] = (f32x4){0.f, 0.f, 0.f, 0.f};
    float mrun = -1e30f, lrun = 0.f;
    const int kc0 = c > 8 ? c - 8 : 0;
    v4u rkA[2], rvA[2], rkB[2], rvB[2];
    const int key0 = tid >> 4, c16 = tid & 15, lo0 = (c16 >> 3) * 64 * AT_P + key0 * AT_P + 8 * (c16 & 7);
    const unsigned short* kg = KB + ((size_t)b * 2048 + key0) * 512 + hp * 128 + 8 * c16; const unsigned short* vg = VB + ((size_t)b * 2048 + key0) * 512 + hp * 128 + 8 * c16;
#define AT_GLOAD(rk, rv, kc_) do { const int kcc = (kc_) <= c ? (kc_) : c; const size_t o_ = (size_t)kcc * 64 * 512; rk[0] = *(const v4u*)(kg + o_); rk[1] = *(const v4u*)(kg + o_ + 32 * 512); rv[0] = *(const v4u*)(vg + o_); rv[1] = *(const v4u*)(vg + o_ + 32 * 512); } while (0)
#define AT_LWRITE(rk, rv, buf_) do { const int l_ = (buf_) * BUFE + lo0; *(LAS v4u*)(Kbuf + l_) = rk[0]; *(LAS v4u*)(Kbuf + l_ + 32 * AT_P) = rk[1]; *(LAS v4u*)(Vbuf + l_) = rv[0]; *(LAS v4u*)(Vbuf + l_ + 32 * AT_P) = rv[1]; } while (0)
#define AT_ARGS(kc_, buf_) accO, mrun, lrun, Kbuf + (buf_) * BUFE + hl * 64 * AT_P, Vbuf + (buf_) * BUFE + hl * 64 * AT_P, qf, ((kc_) - c) * 64 - qoff, tbl, 64, li, q
#define AT_COMPUTE(kc_, buf_) do { if ((kc_) + 3 <= c) attn_block<4, 0>(AT_ARGS(kc_, buf_)); else if ((kc_) + 2 == c) attn_block<4, 2>(AT_ARGS(kc_, buf_)); else attn_block<4, 1>(AT_ARGS(kc_, buf_)); } while (0)
    AT_GLOAD(rkA, rvA, kc0); AT_GLOAD(rkB, rvB, kc0 + 1);
    LDS_BARRIER();
    AT_LWRITE(rkA, rvA, 0);
    LDS_BARRIER();
    for (int kc = kc0; kc <= c; kc += 2) {
        AT_GLOAD(rkA, rvA, kc + 2);
        AT_COMPUTE(kc, 0);
        AT_LWRITE(rkB, rvB, 1);
        LDS_BARRIER();
        if (kc + 1 <= c) {
            AT_GLOAD(rkB, rvB, kc + 3);
            AT_COMPUTE(kc + 1, 1);
            AT_LWRITE(rkA, rvA, 0);
            LDS_BARRIER(); }
    }
#undef AT_GLOAD
#undef AT_LWRITE
#undef AT_COMPUTE
#undef AT_ARGS
    attn_store(accO, lrun, MIX + qrow * 1024 + 512 + head * 64, q);
}
__device__ __forceinline__ void band_sample_unit(LAS unsigned char* lds, const unsigned short* QB, const unsigned short* KB, const unsigned short* VB, const float* ck, const float* cv, unsigned short* MIX, int b, int tid) {
    const int lane = tid & 63, w = __builtin_amdgcn_readfirstlane(tid >> 6), li = lane & 15, q = lane >> 4;
    const LAS float* tbl = (const LAS float*)(lds + AT_TBL) + w * 264;
    constexpr int HE = 32 * AT_P;
    LAS unsigned short* Kbuf = (LAS unsigned short*)(lds + AT_BUF); LAS unsigned short* Vbuf = Kbuf + 8 * HE;
    const size_t qrow = (size_t)MP + b * 16 + li;
    bf16x8 qf[2];
#pragma unroll
    for (int ks = 0; ks < 2; ++ks) qf[ks] = *(const bf16x8*)(QB + qrow * 512 + w * 64 + 32 * ks + 8 * q);
    f32x4 accO[4];
#pragma unroll
    for (int dt = 0; dt < 4; ++dt) accO[dt] = (f32x4){0.f, 0.f, 0.f, 0.f};
    float mrun = -1e30f, lrun = 0.f;
    f32x4 kx[8], vx[8];
#define ATS_GLOAD(kb_) do { _Pragma("unroll") for (int i = 0; i < 8; ++i) { const int fi = tid + 512 * i, key = fi >> 7, c4 = fi & 127; const size_t off = ((size_t)b * 512 + 32 * (kb_) + key) * 512 + 4 * c4; kx[i] = *(const f32x4*)(ck + off); vx[i] = *(const f32x4*)(cv + off); } } while (0)
    ATS_GLOAD(0);
    for (int kb = 0; kb < 16; ++kb) {
        LDS_BARRIER();
#pragma unroll
        for (int i = 0; i < 8; ++i) { const int fi = tid + 512 * i, key = fi >> 7, c4 = fi & 127; const int lo = (c4 >> 4) * HE + key * AT_P + 4 * (c4 & 15);
            u32x2 o; o.x = pk2(kx[i][0], kx[i][1]); o.y = pk2(kx[i][2], kx[i][3]); *(LAS u32x2*)(Kbuf + lo) = o;
            o.x = pk2(vx[i][0], vx[i][1]); o.y = pk2(vx[i][2], vx[i][3]); *(LAS u32x2*)(Vbuf + lo) = o; }
        if (kb + 1 < 16) ATS_GLOAD(kb + 1);
        LDS_BARRIER();
        if (kb <= 11) attn_block<2, 0>(accO, mrun, lrun, Kbuf + w * HE, Vbuf + w * HE, qf, 32 * kb - 512 - li, tbl, 32, li, q);
        else if (kb == 12) attn_block<2, 2>(accO, mrun, lrun, Kbuf + w * HE, Vbuf + w * HE, qf, 32 * kb - 512 - li, tbl, 32, li, q);
        else attn_block<2, 1>(accO, mrun, lrun, Kbuf + w * HE, Vbuf + w * HE, qf, 32 * kb - 512 - li, tbl, 32, li, q);
    }
#undef ATS_GLOAD
    {
        v4u k4[4], v4[4];
#pragma unroll
        for (int c2 = 0; c2 < 4; ++c2) { const int ci = tid + 512 * c2, key = ci >> 6, c16 = ci & 63; const int keyc = key < 16 ? key : 15; const size_t off = ((size_t)MP + b * 16 + keyc) * 512 + 8 * c16;
            k4[c2] = *(const v4u*)(KB + off); v4[c2] = *(const v4u*)(VB + off); }
        LDS_BARRIER();
#pragma unroll
        for (int c2 = 0; c2 < 4; ++c2) { const int ci = tid + 512 * c2, key = ci >> 6, c16 = ci & 63; const int lo = (c16 >> 3) * HE + key * AT_P + 8 * (c16 & 7);
            *(LAS v4u*)(Kbuf + lo) = k4[c2]; *(LAS v4u*)(Vbuf + lo) = v4[c2]; }
        LDS_BARRIER();
        attn_block<2, 3>(accO, mrun, lrun, Kbuf + w * HE, Vbuf + w * HE, qf, -li, tbl, 16, li, q);
    }
    attn_store(accO, lrun, MIX + qrow * 1024 + 512 + w * 64, q);
}

__device__ __forceinline__ void mixer_phase(const Ctx& A, LAS unsigned char* lds, int vcu, int G, int tid) {
    unsigned char* ws = A.ws; float* out = A.out;
    const unsigned short* U = (const unsigned short*)(ws + WS_BIG);
    const unsigned short *QA = U, *KA = U + U_ELEMS, *VA = U + 2 * U_ELEMS, *OA = U + 3 * U_ELEMS, *QB = U + 4 * U_ELEMS, *KB = U + 5 * U_ELEMS, *VB = U + 6 * U_ELEMS;
    unsigned short* MIX = (unsigned short*)(ws + WS_XN); const float* GA = (const float*)(ws + WS_GA);
    const int NSEQ = 64, TRN1 = 2700;
    if (vcu < NSEQ) {
        const int sq_ = vcu >> 1, half = vcu & 1, b = sq_ >> 2, h = sq_ & 3;
        mlstm_seq(lds, QA, KA, VA, OA, GA, MIX, inptr(22) + h * 128, b * 2048, h, half ? 32 : 18, half ? 18 : 0, 64, nullptr, nullptr, nullptr,
                  half ? out + O_PAC + (size_t)(b * 4 + h) * 16384 : nullptr, out + O_PAN + (b * 4 + h) * 128, out + O_PAM + b * 4 + h, tid);
        asm volatile("" : "+v"(tid));
        LDS_BARRIER();
        { const int wv = __builtin_amdgcn_readfirstlane(tid >> 6), k = sq_ * NWAVES + wv;
          p0_weights(A, (LAS float*)(lds + wv * 16384), 3, (half ? 256 : 0) + k, 512, tid & 63, 0, TRN1); }
        return;
    }
    const int wk = vcu - NSEQ, NWK = G - NSEQ;
    { LAS float* tb = (LAS float*)(lds + AT_TBL); for (int i = tid; i < 8 * 257; i += 512) tb[(i / 257) * 264 + (i % 257)] = inptr(25)[i] * 1.4426950408889634f; }
    constexpr int N_BS = 32, N_MS = 128, N_BP = 1024;
    if (NWK == 192) {
        const int quota = wk < 32 ? 4 : (wk < 96 ? 6 : (wk < 160 ? 5 : 6));
        asm volatile("" : "+v"(tid));
        if (wk < N_BS) band_sample_unit(lds, QB, KB, VB, inptr(5), inptr(6), MIX, wk, tid);
        else if (wk < N_BS + N_MS) { const int u = wk - N_BS, b = u >> 2, h = u & 3;
            mlstm_seq(lds, QA, KA, VA, OA, GA, MIX, inptr(22) + h * 128, MP + b * 16, h, 1, 0, 16,
                      inptr(2) + (size_t)(b * 4 + h) * 16384, inptr(3) + (b * 4 + h) * 128, inptr(4) + b * 4 + h,
                      out + O_SAC + (size_t)(b * 4 + h) * 16384, out + O_SAN + (b * 4 + h) * 128, out + O_SAM + b * 4 + h, tid); }
        for (int r = 0; r < quota; ++r) {
            asm volatile("" : "+v"(tid));
            const int u = r < 4 ? r * 192 + wk : (r == 4 ? 768 + (wk - 32) : 928 + (wk < 96 ? wk - 32 : 64 + (wk - 160)));
            const int hp = u & 3, c = (u >> 2) & 31, b = u >> 7; band_prompt_unit(lds, QB, KB, VB, MIX, b, c, hp, tid); }
    } else
    for (int rep = 0; rep < NREP(62); ++rep)
    for (int it = wk; it < N_BS + N_MS + N_BP; it += NWK) {
        asm volatile("" : "+v"(tid));
        if (it < N_BS) { band_sample_unit(lds, QB, KB, VB, inptr(5), inptr(6), MIX, it, tid); }
        else if (it < N_BS + N_MS) { const int u = it - N_BS, b = u >> 2, h = u & 3;
            mlstm_seq(lds, QA, KA, VA, OA, GA, MIX, inptr(22) + h * 128, MP + b * 16, h, 1, 0, 16,
                      inptr(2) + (size_t)(b * 4 + h) * 16384, inptr(3) + (b * 4 + h) * 128, inptr(4) + b * 4 + h,
                      out + O_SAC + (size_t)(b * 4 + h) * 16384, out + O_SAN + (b * 4 + h) * 128, out + O_SAM + b * 4 + h, tid); }
        else { const int u = it - N_BS - N_MS, hp = u & 3, c = (u >> 2) & 31, b = u >> 7; band_prompt_unit(lds, QB, KB, VB, MIX, b, c, hp, tid); }
    }
    asm volatile("" : "+v"(tid));
    LDS_BARRIER();
#if FOLD & 1
    bias_wg((const unsigned short*)(ws + WS_WFIN) + (size_t)2 * FIN_ELEMS, (const float*)(ws + WS_ADA) + 6 * 1024, (float*)(ws + WS_BIAS), lds, wk, NWK, tid);
    LDS_BARRIER();
#endif
    { const int wv = __builtin_amdgcn_readfirstlane(tid >> 6); p0_weights(A, (LAS float*)(lds + wv * 16384), 3, wk * NWAVES + wv, NWK * NWAVES, tid & 63, TRN1, -1); }
}

constexpr int RG_XB = 0, RG_GB = 18432, RG_XCB = 35840, RG_XCF = 53248, RG_Y = 87040, RG_HIN = 104448, RG_P = 108544;
constexpr int RGP = 136, RGF = 132;
__device__ __forceinline__ void rglru_unit(const Ctx& A, LAS unsigned char* lds, bool sample, int b, int tt, int nb0, int nb1, int tid) {
    unsigned char* ws = A.ws; float* out = A.out;
    const unsigned short* GBg = (const unsigned short*)(ws + WS_BIG); const unsigned short* XBg = GBg + (size_t)MT * 1024;
    unsigned short* YC = (unsigned short*)(ws + WS_XN); unsigned short* YP = (unsigned short*)(ws + WS_BIG) + (size_t)2 * MT * 1024; const unsigned short* GW = (const unsigned short*)(ws + WS_WGATE);
    float* CA = (float*)(ws + WS_CARRY); float* CU = CA + 8 * 32 * 1024;
    const int lane = tid & 63, w = __builtin_amdgcn_readfirstlane(tid >> 6), li = lane & 15, q = lane >> 4;
    const int L = sample ? 16 : 64, MTL = sample ? 1 : 4, row0 = sample ? MP + 16 * b : b * 2048 + 64 * tt;
    LAS unsigned short* XBs = (LAS unsigned short*)(lds + RG_XB); LAS unsigned short* GBs = (LAS unsigned short*)(lds + RG_GB); LAS unsigned short* XCB = (LAS unsigned short*)(lds + RG_XCB);
    LAS float* XCF = (LAS float*)(lds + RG_XCF); LAS unsigned short* Ys = (LAS unsigned short*)(lds + RG_Y); LAS float* hin = (LAS float*)(lds + RG_HIN); LAS unsigned short* Ps = (LAS unsigned short*)(lds + RG_P);
    const float* cstate = inptr(7);
    v4u xr[3], gr[2]; bf16x8 wr_[4], wi_[4];
    const v4u z4 = {0u, 0u, 0u, 0u};
    const float* convw = inptr(28); const float* convb = inptr(29); const float* gateb = inptr(31); const float* lam = inptr(32);
    float pw0, pw1, pw2, pw3, pcb, pgr, pgi, plm;
    const int nxc = (L + 3) * 16, ngc = L * 16;
#define RG_PREFETCH(n_) do { const int ch0_ = 128 * (n_); \
        _Pragma("unroll") for (int i = 0; i < 3; ++i) { const int ci0 = tid + 512 * i, ci = ci0 < nxc ? ci0 : nxc - 1, r = ci >> 4, c16 = ci & 15, tr = r - 3; \
            const bool use = (tr >= 0) || (!sample && tt > 0); const int trc = use ? tr : 0; \
            const v4u ld = *(const v4u*)(XBg + (size_t)(row0 + trc) * 1024 + ch0_ + 8 * c16); xr[i] = use ? ld : z4; } \
        if (sample && tid < 48) { const int r = tid >> 4, c16 = tid & 15; const float* cp = cstate + ((size_t)b * 3 + r) * 1024 + ch0_ + 8 * c16; const f32x4 c0 = *(const f32x4*)cp, c1 = *(const f32x4*)(cp + 4); \
            xr[0].x = pk2(c0[0], c0[1]); xr[0].y = pk2(c0[2], c0[3]); xr[0].z = pk2(c1[0], c1[1]); xr[0].w = pk2(c1[2], c1[3]); } \
        { _Pragma("unroll") for (int i = 0; i < 2; ++i) { const int ci0 = tid + 512 * i, ci = ci0 < ngc ? ci0 : ngc - 1, r = ci >> 4, c16 = ci & 15; gr[i] = *(const v4u*)(GBg + (size_t)(row0 + r) * 1024 + ch0_ + 8 * c16); } } \
        { const int cc = ch0_ + (tid & 127), cg = ch0_ + 16 * w + li; pw0 = convw[cc]; pw1 = convw[1024 + cc]; pw2 = convw[2048 + cc]; pw3 = convw[3072 + cc]; pcb = convb[cc]; pgr = gateb[cg]; pgi = gateb[1024 + cg]; plm = lam[cg]; } } while (0)
    float hv2[2] = {0.f, 0.f};
    if (sample) { hv2[0] = inptr(8)[(size_t)b * 1024 + tid]; hv2[1] = inptr(8)[(size_t)b * 1024 + tid + 512]; }
#define RG_PREFETCH_W(n_) do { _Pragma("unroll") for (int ks = 0; ks < 4; ++ks) { wr_[ks] = *(const bf16x8*)(GW + ((unsigned)(n_) * 256u + 16u * w + li) * 128u + 32u * ks + 8u * q); wi_[ks] = *(const bf16x8*)(GW + ((unsigned)(n_) * 256u + 128u + 16u * w + li) * 128u + 32u * ks + 8u * q); } } while (0)
    RG_PREFETCH(nb0); RG_PREFETCH_W(nb0);
    LDS_BARRIER();
    hin[tid] = hv2[0]; hin[tid + 512] = hv2[1];
    for (int n = nb0; n < nb1; ++n) {
        const int ch0 = 128 * n;
#pragma unroll
        for (int i = 0; i < 3; ++i) { const int ci = tid + 512 * i, r = ci >> 4, c16 = ci & 15; if (ci < nxc) *(LAS v4u*)(XBs + r * RGP + 8 * c16) = xr[i]; }
#pragma unroll
        for (int i = 0; i < 2; ++i) { const int ci = tid + 512 * i, r = ci >> 4, c16 = ci & 15; if (ci < L * 16) *(LAS v4u*)(GBs + r * RGP + 8 * c16) = gr[i]; }
        const int chn = ch0 + 16 * w + li;
        const float gbr = pgr, gbi = pgi, lm = plm;
        const int chl = tid & 127, tg = tid >> 7;
        const float w0 = pw0, w1 = pw1, w2 = pw2, w3 = pw3, cb = pcb;
        if (n + 1 < nb1) RG_PREFETCH(n + 1);
        LDS_BARRIER();
        if (tg * 16 < L) {
            const LAS unsigned short* xb0 = XBs + tg * 16 * RGP + chl; LAS float* xf0 = XCF + tg * 16 * RGF + chl; LAS unsigned short* xc0 = XCB + tg * 16 * RGP + chl;
            float xv[19];
#pragma unroll
            for (int i = 0; i < 19; ++i) xv[i] = bf2f(xb0[i * RGP]);
#pragma unroll
            for (int i = 0; i < 16; ++i) { const float xc = cb + w0 * xv[i] + w1 * xv[i + 1] + w2 * xv[i + 2] + w3 * xv[i + 3];
                xf0[i * RGF] = xc; xc0[i * RGP] = (unsigned short)(pk2(xc, 0.f) & 0xffffu); } }
        LDS_BARRIER();
        const float sp8l = 8.0f * 1.4426950408889634f * (fmaxf(-lm, 0.f) + log1pf(expf(-fabsf(lm))));
        float aa[4][4], uu[4][4];
        const LAS unsigned short* xcb0 = XCB + li * RGP + 8 * q; const LAS float* xcf0 = XCF + 4 * q * RGF + 16 * w + li;
        const LAS unsigned short* gb0 = GBs + 4 * q * RGP + 16 * w + li; LAS unsigned short* y0 = Ys + 4 * q * RGP + 16 * w + li; LAS unsigned short* p0 = Ps + 4 * q * RGP + 16 * w + li;
#pragma unroll
        for (int mt = 0; mt < 4; ++mt) {
            if (mt < MTL) { f32x4 ar = {0.f, 0.f, 0.f, 0.f}, ai = {0.f, 0.f, 0.f, 0.f};
#pragma unroll
                for (int ks = 0; ks < 4; ++ks) { const bf16x8 a = *(const LAS bf16x8*)(xcb0 + 16 * mt * RGP + 32 * ks); ar = mfma16(a, wr_[ks], ar); ai = mfma16(a, wi_[ks], ai); }
#pragma unroll
                for (int r = 0; r < 4; ++r) { const float rr = fast_sigmoid(ar[r] + gbr), ii = fast_sigmoid(ai[r] + gbi);
                    const float av_ = __builtin_amdgcn_exp2f(-sp8l * rr);
                    const float em = fmaxf(1.0f - av_ * av_, 0.f);
                    aa[mt][r] = av_; uu[mt][r] = __builtin_amdgcn_sqrtf(em) * ii * xcf0[(16 * mt + r) * RGF]; }
            } else {
#pragma unroll
                for (int r = 0; r < 4; ++r) { aa[mt][r] = 1.f; uu[mt][r] = 0.f; } } }
        if (n + 1 < nb1) RG_PREFETCH_W(n + 1);
        float hcar = hin[chn], atot = 1.f;
#pragma unroll
        for (int mt = 0; mt < 4; ++mt) { float sa = 1.f, su = 0.f;
#pragma unroll
            for (int r = 0; r < 4; ++r) { su = aa[mt][r] * su + uu[mt][r]; sa *= aa[mt][r]; }
            float myin = 0.f, myp = 1.f;
#pragma unroll
            for (int q2 = 0; q2 < 4; ++q2) { const float a2 = bperm(sa, li + 16 * q2), u2 = bperm(su, li + 16 * q2); myin = (q2 == q) ? hcar : myin; myp = (q2 == q) ? atot : myp; hcar = a2 * hcar + u2; atot *= a2; }
            if (mt < MTL) { float hh = myin, pp = myp;
#pragma unroll
                for (int r = 0; r < 4; ++r) { hh = aa[mt][r] * hh + uu[mt][r]; pp *= aa[mt][r];
                    const float g = bf2f(gb0[(16 * mt + r) * RGP]);
                    const float ge = g * __builtin_amdgcn_rcpf(1.0f + __builtin_amdgcn_exp2f(g * (-2.3022082f + -0.10294324f * (g * g))));
                    const unsigned pk = pk2(ge * hh, ge * pp);
                    y0[(16 * mt + r) * RGP] = (unsigned short)(pk & 0xffffu); p0[(16 * mt + r) * RGP] = (unsigned short)(pk >> 16); } } }
        if (q == 0) { if (sample) out[O_SCH + (size_t)b * 1024 + chn] = hcar; else { CA[((size_t)b * 1024 + chn) * 32 + tt] = atot; CU[((size_t)b * 1024 + chn) * 32 + tt] = hcar; } }
        LDS_BARRIER();
        for (int ci = tid; ci < L * 16; ci += 512) { const int r = ci >> 4, c16 = ci & 15; *(v4u*)(YC + (size_t)(row0 + r) * 1024 + ch0 + 8 * c16) = *(const LAS v4u*)(Ys + r * RGP + 8 * c16);
            if (!sample) *(v4u*)(YP + (size_t)(row0 + r) * 1024 + ch0 + 8 * c16) = *(const LAS v4u*)(Ps + r * RGP + 8 * c16); }
    }
#undef RG_PREFETCH
#undef RG_PREFETCH_W
}

__device__ __forceinline__ void rglru_fix(const Ctx& A, LAS unsigned char* lds, int b, int tt, int tid) {
    unsigned char* ws = A.ws; float* out = A.out;
    unsigned short* YC = (unsigned short*)(ws + WS_XN); const unsigned short* YP = (const unsigned short*)(ws + WS_BIG) + (size_t)2 * MT * 1024;
    const float* CA = (const float*)(ws + WS_CARRY); const float* CU = CA + 8 * 32 * 1024;
    LAS float* hin = (LAS float*)(lds + RG_HIN);
    const int row0 = b * 2048 + 64 * tt;
    float hv2[2];
#pragma unroll
    for (int e = 0; e < 2; ++e) { const int chn = tid + 512 * e;
        f32x4 ca[8], cu[8]; const f32x4* cap = (const f32x4*)(CA + ((size_t)b * 1024 + chn) * 32); const f32x4* cup = (const f32x4*)(CU + ((size_t)b * 1024 + chn) * 32);
#pragma unroll
        for (int k = 0; k < 8; ++k) { ca[k] = cap[k]; cu[k] = cup[k]; }
        float hv = 0.f, hall = 0.f;
#pragma unroll
        for (int k = 0; k < 32; ++k) { hall = ca[k >> 2][k & 3] * hall + cu[k >> 2][k & 3]; hv = (k + 1 == tt) ? hall : hv; }
        hv2[e] = hv;
        if (tt == 31) out[O_PCH + (size_t)b * 1024 + chn] = hall; }
    LDS_BARRIER();
    hin[tid] = hv2[0]; hin[tid + 512] = hv2[1];
    LDS_BARRIER();
    if (tt > 0) {
#pragma unroll 1
        for (int half = 0; half < 2; ++half) {
            v4u y0r[8], ypr[8];
#pragma unroll
            for (int i = 0; i < 8; ++i) { const int ci = tid + 512 * (8 * half + i), r = ci >> 7, c8 = ci & 127; const size_t o = (size_t)(row0 + r) * 1024 + 8 * c8; y0r[i] = *(const v4u*)(YC + o); ypr[i] = *(const v4u*)(YP + o); }
#pragma unroll
            for (int i = 0; i < 8; ++i) { const int ci = tid + 512 * (8 * half + i), r = ci >> 7, c8 = ci & 127; const size_t o = (size_t)(row0 + r) * 1024 + 8 * c8;
                const f32x4 h0 = *(const LAS f32x4*)(hin + 8 * c8), h1 = *(const LAS f32x4*)(hin + 8 * c8 + 4);
                v4u w;
                w.x = pk2(bflo(y0r[i].x) + bflo(ypr[i].x) * h0[0], bfhi(y0r[i].x) + bfhi(ypr[i].x) * h0[1]); w.y = pk2(bflo(y0r[i].y) + bflo(ypr[i].y) * h0[2], bfhi(y0r[i].y) + bfhi(ypr[i].y) * h0[3]);
                w.z = pk2(bflo(y0r[i].z) + bflo(ypr[i].z) * h1[0], bfhi(y0r[i].z) + bfhi(ypr[i].z) * h1[1]); w.w = pk2(bflo(y0r[i].w) + bflo(ypr[i].w) * h1[2], bfhi(y0r[i].w) + bfhi(ypr[i].w) * h1[3]);
                *(v4u*)(YC + o) = w; } } }
}

__device__ __forceinline__ int mytid_fn(int wave_s) { unsigned ones = ~0u; asm volatile("" : "+s"(ones));
    return wave_s * 64 + (int)__builtin_amdgcn_mbcnt_hi(ones, __builtin_amdgcn_mbcnt_lo(ones, 0u)); }
#ifndef DUP_P0
#define DUP_P0 0
#endif

#ifdef NO_GEMM
#define GEMM_CALL if (false)
#else
#define GEMM_CALL
#endif
__global__ void __launch_bounds__(NWAVES * 64, 2) fwd_megakernel(Args args) {
    extern __shared__ __attribute__((aligned(16))) unsigned char lds_raw[];
    LAS unsigned char* lds = (LAS unsigned char*)lds_raw;
    volatile LAS unsigned* MISC = (volatile LAS unsigned*)(lds + MISC_OFF);
    const int wave_s = __builtin_amdgcn_readfirstlane((int)threadIdx.x >> 6);
#define MYTID() mytid_fn(wave_s)
    int tid = MYTID(), G = gridDim.x, bx = blockIdx.x;
    unsigned char* ws = args.ws; float* out = args.out;
#define lane (tid & 63)
#define wave (__builtin_amdgcn_readfirstlane(tid >> 6))
#define vcu ((G % 8 == 0) ? (bx % 8) * (G / 8) + bx / 8 : bx)
#define gw (vcu * NWAVES + wave)
#define NGW (G * NWAVES)
    gu32* ctl = (gu32*)(ws + WS_CTL);
    for (int u = tid; u < (LDS_BYTES - LDSCTL_OFF) / 4; u += NWAVES * 64) ((LAS unsigned*)(lds + LDSCTL_OFF))[u] = 0u;
    __syncthreads();
    XcdBarrier bar = xcd_barrier_post((unsigned*)(ctl + CW_BAR), MISC + 8);
#define GRID_BAR() do { xcd_barrier(bar, MYTID() == 0); tid = MYTID(); G = gridDim.x; bx = blockIdx.x; asm volatile("" : "+v"(tid)); asm volatile("" : "+s"(G), "+s"(bx)); } while (0)
#define ADAP ((float*)(ws + WS_ADAP))
#define ADA ((float*)(ws + WS_ADA))
#define XN ((unsigned short*)(ws + WS_XN))
#define BIG ((unsigned short*)(ws + WS_BIG))
#define XR ((unsigned short*)(ws + WS_XR))

    for (int rep = 0; rep < ((DUP_P0) ? 2 : 1); ++rep)
    {
#ifndef NO_ADA
      for (int wgi = vcu; wgi < 256; wgi += G) p0_ada_mfma(inptr(9), inptr(10), inptr(18), ADAP, lds, wgi, tid);
#endif
      __syncthreads();
#ifndef NO_P0W
      p0_weights(Ctx{out, ws}, (LAS float*)(lds + wave * 16384), 0, gw, NGW, lane);
#endif
    GRID_BAR(); }

    for (int l = 0; l < 2; ++l) {
        for (int s = 0; s < 3; ++s) {
            const bool first = (l == 0 && s == 0);
            const int fidx = s == 1 ? 3 : (s == 2 ? 2 * l : 1); const bool fold = !first && (s != 1 || l == 1) && ((FOLD >> fidx) & 1);
            const int sp_ = s == 0 ? 2 : s - 1, lp_ = s == 0 ? l - 1 : l;
            const bool xs_big = fold && sp_ == 1 && s != 1;
            unsigned short* const XSb = (s == 1) ? (unsigned short*)(ws + WS_XS3) : (xs_big ? BIG : XN);
            if (!fold)
            for (int rep = 0; rep < NREP(2); ++rep) {
                const float* adaL = ADA + (size_t)l * NBR * NADA;
                const float* nw = inptr(s == 0 ? 11 : (s == 1 ? 14 : 15)) + (size_t)l * D;
                const int sp = s == 0 ? 2 : s - 1, lp = s == 0 ? l - 1 : l;
                const float* fx_slab = (const float*)(ws + WS_SLAB); const int fx_npart = first ? 0 : (sp == 1 ? 8 : 11); const bool fx_bf32 = (l == 0 && s == 1);
                const float* fx_gate = ADA + (size_t)(lp < 0 ? 0 : lp) * NBR * NADA + (3 * sp + 2) * 1024; const float fx_s = sp == 1 ? 1.0f : 0.5f;
                if (l == 0 && s == 1) norm_phase<true>(inptr(0), inptr(1), XR, first, nw, adaL, 3 * s, XN, inptr(20), inptr(21), (float*)(ws + WS_GA), (LAS float*)lds, fx_slab, fx_npart, fx_bf32, fx_gate, fx_s, (rep + 1 < NREP(2)), first ? ADAP : nullptr, inptr(19), ADA, gw, NGW, lane, tid);
                else norm_phase<false>(inptr(0), inptr(1), XR, first, nw, adaL, 3 * s, XN, nullptr, nullptr, nullptr, (LAS float*)lds, fx_slab, fx_npart, fx_bf32, fx_gate, fx_s, (rep + 1 < NREP(2)), first ? ADAP : nullptr, inptr(19), ADA, gw, NGW, lane, tid);
                GRID_BAR();
            }
            int rsel;
            if (s != 1) {
                const int f = (s == 0 ? 0 : 2) + l;
                unsigned short* const Hb = xs_big ? (unsigned short*)(ws + WS_H2) : BIG;
                for (int rep = 0; rep < NREP(3); ++rep) {
                  const int nlight = G - (66 * 22) % G, li0 = bx - (66 * 22) % G;
                  unsigned* sctr = (unsigned*)(ctl + (CTL_SCTR + 256 * fidx) / 4);
                  if (fold && rep == 0 && li0 >= 0 && nlight < G) {
                      const float* adaL = ADA + (size_t)l * NBR * NADA;
                      sample_fold(XR, (const float*)(ws + WS_SLAB), sp_ == 1 ? 8 : 11, ADA + (size_t)lp_ * NBR * NADA + (3 * sp_ + 2) * 1024, sp_ == 1 ? 1.0f : 0.5f,
                                  inptr(s == 0 ? 11 : 15) + (size_t)l * D, adaL, 3 * s, XSb, (LAS float*)lds, sctr, li0, nlight, tid); }
                  pg8::Gemm g{fold ? XSb : XN, (const unsigned short*)(ws + WS_WFIN) + (size_t)f * FIN_ELEMS, MT, 2 * DFF, D};
                  if (fold) { pg8::GatedOrder S; S.init(MT, 2 * DFF, G, bx, D); S.ctr = sctr; S.need = (unsigned)nlight; S.seen = 0;
                      pg8::EpiSwigluT<true> E{Hb, DFF, (const unsigned long long*)(ws + CTL_SSQ) + (size_t)fidx * MP, (const float*)(ws + WS_BIAS) + (size_t)fidx * NBR * 5632, (LAS float*)(lds + LDSCTL_OFF + 1024)};
                      GEMM_CALL pg8::gemm_phase<pg8::EpiSwigluT<true>, pg8::GatedOrder, true, true>(lds, g, S, E, tid); }
                  else { pg8::StaticOrder S; S.init(MT, 2 * DFF, G, bx, D);
                      pg8::EpiSwiglu E{Hb, DFF, nullptr, nullptr, nullptr};
                      GEMM_CALL pg8::gemm_phase<pg8::EpiSwiglu, pg8::StaticOrder, true, true>(lds, g, S, E, tid); }
                  if (first) {
                      if (li0 >= 0 && nlight < G) p0_weights(Ctx{out, ws}, (LAS float*)(lds + wave * 16384), 1, li0 * NWAVES + wave, nlight * NWAVES, lane); }
                  if (((l == 0 && s == 2 && (FOLD & 10)) || (l == 1 && s == 0 && (FOLD & 4))) && li0 >= 0 && nlight < G) {
                      tid = MYTID(); asm volatile("" : "+v"(tid));
                      const int fn = s == 2 ? 1 : 3, jn = s == 2 ? 0 : 6, fi = s == 2 ? 1 : 2;
                      bias_wg((const unsigned short*)(ws + WS_WFIN) + (size_t)fn * FIN_ELEMS, ADA + (size_t)NBR * NADA + jn * 1024, (float*)(ws + WS_BIAS) + (size_t)fi * NBR * 5632, lds, li0, nlight, tid);
                      if (s == 2 && (FOLD & 8)) bias_wg((const unsigned short*)(ws + WS_WCIN), ADA + (size_t)NBR * NADA + 3 * 1024, (float*)(ws + WS_BIASC), lds, li0, nlight, tid, 64, 2048); }
                  GRID_BAR(); }
                rsel = 0;
            } else if (l == 0) {
                for (int rep = 0; rep < ((DUP == 5 || DUP == 51) ? 2 : 1); ++rep) {
                  pg8::Gemm g{XN, (const unsigned short*)(ws + WS_WABIN), MT, 3584, D}; pg8::StaticOrder S; S.init(MT, 3584, G, bx, D);
                  pg8::EpiABin E{BIG, U_ELEMS, inptr(23), inptr(24), out + O_PBK, out + O_PBV, out + O_SBK, out + O_SBV, EPS, (DUP == 51 && rep == 0) ? 1 : 0};
                  GEMM_CALL pg8::gemm_phase<pg8::EpiABin, pg8::StaticOrder, true, true>(lds, g, S, E, tid);
                  { const int nlight = G - (66 * 14) % G, li0 = bx - (66 * 14) % G;
                      if (li0 >= 0 && nlight < G) p0_weights(Ctx{out, ws}, (LAS float*)(lds + wave * 16384), 2, li0 * NWAVES + wave, nlight * NWAVES, lane); }
                  GRID_BAR(); }
                for (int rep = 0; rep < NREP(6); ++rep) {
#ifndef NO_MIXER
                  mixer_phase(Ctx{out, ws}, lds, bx, G, tid);
#endif
                  GRID_BAR(); }
                rsel = 1;
            } else {
                for (int rep = 0; rep < NREP(7); ++rep) {
                  pg8::Gemm g{fold ? XSb : XN, (const unsigned short*)(ws + WS_WCIN), MT, 2048, D};
                  if (fold) {
                      const int nheavy = (66 * 8) % G, li0 = bx - nheavy, nlight = G - nheavy;
                      unsigned* sctr = (unsigned*)(ctl + (CTL_SCTR + 256 * fidx) / 4);
                      if (rep == 0 && li0 >= 0 && nlight < G) { const float* adaL = ADA + (size_t)l * NBR * NADA;
                          sample_fold(XR, (const float*)(ws + WS_SLAB), 11, ADA + (size_t)lp_ * NBR * NADA + (3 * sp_ + 2) * 1024, 0.5f, inptr(14) + (size_t)l * D, adaL, 3 * s, XSb, (LAS float*)lds, sctr, li0, nlight, tid); }
                      pg8::GatedOrder S; S.init(MT, 2048, G, bx, D); S.ctr = sctr; S.need = (unsigned)nlight; S.seen = 0;
                      pg8::EpiCinT<true> E{BIG, BIG + (size_t)MT * 1024, out + O_PCC, out + O_SCC, (const unsigned long long*)(ws + CTL_SSQ) + (size_t)fidx * MP, (const float*)(ws + WS_BIASC), (LAS float*)(lds + LDSCTL_OFF + 1024)};
                      GEMM_CALL pg8::gemm_phase<pg8::EpiCinT<true>, pg8::GatedOrder, true, true>(lds, g, S, E, tid); }
                  else { pg8::StaticOrder S; S.init(MT, 2048, G, bx, D);
                      pg8::EpiCin E{BIG, BIG + (size_t)MT * 1024, out + O_PCC, out + O_SCC, nullptr, nullptr, nullptr};
                      GEMM_CALL pg8::gemm_phase<pg8::EpiCin, pg8::StaticOrder, true, true>(lds, g, S, E, tid); }
                  GRID_BAR(); }
                for (int rep = 0; rep < NREP(8); ++rep) {
                  for (int u = vcu; u < 512; u += G) { if (u < 256) rglru_unit(Ctx{out, ws}, lds, false, u >> 5, u & 31, 0, 8, tid);
                      else { const int j = u - 256; rglru_unit(Ctx{out, ws}, lds, true, j >> 3, 0, j & 7, (j & 7) + 1, tid); } }
                  GRID_BAR();
                  for (int u = vcu; u < 256; u += G) rglru_fix(Ctx{out, ws}, lds, u >> 5, u & 31, tid);
                  GRID_BAR(); }
                rsel = 2;
            }
#if DUP == 9
            GRID_BAR();
#endif
            for (int rep = 0; rep < NREP(4); ++rep) { const bool lastr = (l == 1 && s == 2);
              const float* adaL = ADA + (size_t)l * NBR * NADA;
              const int f = (s == 0 ? 0 : 2) + l;
              const unsigned short* rA = rsel == 0 ? (xs_big ? (const unsigned short*)(ws + WS_H2) : BIG) : XN;
              const int sn = s == 2 ? 0 : s + 1, ln = s == 2 ? l + 1 : l, fnx = sn == 1 ? 3 : (sn == 2 ? 2 * ln : 1);
              const bool foldn = ln < 2 && (sn != 1 || ln == 1) && ((FOLD_RES >> fnx) & 1);
              const unsigned short* rB = rsel == 0 ? (const unsigned short*)(ws + WS_WFOUT) + (size_t)f * FOUT_ELEMS : (const unsigned short*)(ws + (rsel == 1 ? WS_WABOUT : WS_WCOUT));
              pg8::Gemm g{rA, rB, MT, D, rsel == 0 ? DFF : D}; pg8::ResOrder S; S.init(G, bx, rsel == 0 ? DFF : D, rsel == 0 ? 4 : 2);
              pg8::EpiRes E{inptr(0), inptr(1), XR, out, adaL + (3 * s + 2) * 1024, rsel == 0 ? 0.5f : 1.0f, (float*)(ws + WS_SLAB), first ? 1 : 0, lastr ? 1 : 0, (rep + 1 < NREP(4)) ? (unsigned short*)(ws + WS_END) : nullptr,
                            foldn ? (sn == 1 ? (unsigned short*)(ws + WS_XS3) : (rsel == 0 ? XN : BIG)) : nullptr, inptr(sn == 0 ? 11 : (sn == 1 ? 14 : 15)) + (size_t)(ln & 1) * D, ADA + (size_t)(ln & 1) * NBR * NADA + (3 * sn + 1) * 1024, (unsigned long long*)(ws + CTL_SSQ) + (size_t)fnx * MP,
                            (foldn && ln < 2 && ((FOLD >> fnx) & 1)) ? 1 : 0, fold ? XSb : nullptr, inptr(s == 0 ? 11 : (s == 1 ? 14 : 15)) + (size_t)l * D, adaL + (3 * s + 1) * 1024};
              GEMM_CALL pg8::gemm_phase<pg8::EpiRes, pg8::ResOrder, true, true>(lds, g, S, E, tid);
              GRID_BAR(); }
        }
    }
    { f32x4 v[4]; for (int row = MP + gw; row < MT; row += NGW) fix_row(v, row, nullptr, XR, (const float*)(ws + WS_SLAB), 11, false, ADA + (size_t)NBR * NADA + 8 * 1024, 0.5f, out, lane); }
}

extern "C" void kernel_launch(void* const* d_in, const int* in_sizes, int n_in, void* d_out, int out_size, void* d_ws, size_t ws_size, hipStream_t stream) {
    static int grid = 0;
    if (grid == 0) {
        if (n_in != 34 || (size_t)out_size != O_TOTAL || ws_size < WS_END) { fprintf(stderr, "kernel_launch: unexpected problem: n_in %d out %d ws %zu\n", n_in, out_size, ws_size); grid = -1; return; }
        int dev = 0, cus = 0, per_cu = 0;
        if (hipGetDevice(&dev) != hipSuccess || hipDeviceGetAttribute(&cus, hipDeviceAttributeMultiprocessorCount, dev) != hipSuccess) { grid = -1; return; }
        if (hipFuncSetAttribute((const void*)fwd_megakernel, hipFuncAttributeMaxDynamicSharedMemorySize, LDS_BYTES) != hipSuccess) { fprintf(stderr, "kernel_launch: hipFuncSetAttribute failed\n"); grid = -1; return; }
        if (hipOccupancyMaxActiveBlocksPerMultiprocessor(&per_cu, (const void*)fwd_megakernel, NWAVES * 64, LDS_BYTES) != hipSuccess || per_cu < 1) fprintf(stderr, "kernel_launch: occupancy query says %d\n", per_cu);
        (void)hipGetLastError();
        grid = cus;
    }
    if (grid < 0) return;
    (void)hipMemsetAsync((char*)d_ws + WS_CTL, 0, CTL_ZERO_BYTES, stream);
    Args a{};
    for (int i = 0; i < 34; ++i) a.in[i] = (const float*)d_in[i];
    a.out = (float*)d_out; a.ws = (unsigned char*)d_ws;
    hipLaunchKernelGGL(fwd_megakernel, dim3(grid), dim3(NWAVES * 64), LDS_BYTES, stream, a);
}
```
